# Optimizing an MI355X kernel written in HIP

```python
import math
import jax, jax.numpy as jnp
from jax import lax
import numpy as np

D_MODEL = 2048
BATCH = 4
SEQ = 4096
DEPTH = 1

HEAD_DIM = 128
SB_HEADS = D_MODEL // (2 * HEAD_DIM)
RET_HEADS = D_MODEL // (2 * HEAD_DIM)
SB_WIDTH = SB_HEADS * HEAD_DIM
RET_WIDTH = RET_HEADS * HEAD_DIM
MIX_WIDTH = SB_WIDTH + RET_WIDTH
IN_COLS = 3 * SB_WIDTH + 4 * RET_WIDTH
Q_BLOCK = 128
RET_CHUNK = 128
ROPE_BASE = 10000.0
N_EXPERTS = 64
TOP_K = 8
N_GROUPS = 8
TOPK_GROUP = 4
EXPERT_DIM = D_MODEL // 4
SHARED_DIM = D_MODEL // 4
ROUTED_SCALE = 2.5
MOE_BLOCK = 128
EPS = 1e-6

kernel_name = 'hybrid_sbattn_retention_moe_adaln'


def rmsnorm(x, g):
    xf = x.astype(jnp.float32)
    y = xf * lax.rsqrt(jnp.mean(xf * xf, axis=-1, keepdims=True) + EPS)
    return (y * g.astype(jnp.float32)).astype(x.dtype)


def modulate(h, shift, scale):
    return h * (1.0 + scale[:, None, :]) + shift[:, None, :]


def rope_tables(S):
    pos = jnp.arange(S, dtype=jnp.float32)
    inv_freq = ROPE_BASE ** (-jnp.arange(0, HEAD_DIM, 2, dtype=jnp.float32) / HEAD_DIM)
    ang = pos[:, None] * inv_freq[None, :]
    return jnp.cos(ang)[:, None, :], jnp.sin(ang)[:, None, :]


def apply_rope(t, cos, sin):
    t1, t2 = t[..., :HEAD_DIM // 2], t[..., HEAD_DIM // 2:]
    return jnp.concatenate([t1 * cos - t2 * sin, t1 * sin + t2 * cos], axis=-1)


def stick_breaking_attention(q, k, v):
    B, S, H, dh = q.shape
    qf = jnp.transpose(q.astype(jnp.float32), (0, 2, 1, 3)) * (dh ** -0.5)
    kf = jnp.transpose(k.astype(jnp.float32), (0, 2, 1, 3))
    vf = jnp.transpose(v.astype(jnp.float32), (0, 2, 1, 3))
    nq = S // Q_BLOCK
    qb = jnp.transpose(qf.reshape(B, H, nq, Q_BLOCK, dh), (2, 0, 1, 3, 4))
    key_pos = jnp.arange(S, dtype=jnp.int32)

    def block(args):
        q_blk, t0 = args
        z = jnp.einsum('bhqd,bhkd->bhqk', q_blk, kf)
        qpos = t0 + jnp.arange(Q_BLOCK, dtype=jnp.int32)
        causal = key_pos[None, :] < qpos[:, None]
        log_surv = jnp.where(causal, jax.nn.log_sigmoid(-z), 0.0)
        after = lax.cumsum(log_surv, axis=3, reverse=True) - log_surv
        a = jnp.where(causal, jnp.exp(jax.nn.log_sigmoid(z) + after), 0.0)
        return jnp.einsum('bhqk,bhkd->bhqd', a, vf)

    ob = lax.map(block, (qb, jnp.arange(nq, dtype=jnp.int32) * Q_BLOCK))
    return jnp.transpose(ob, (1, 0, 3, 2, 4)).reshape(B, S, H * dh)


def chunkwise_retention(q, k, v):
    B, S, H, dh = q.shape
    C = RET_CHUNK
    N = S // C

    def to_chunks(t):
        return jnp.transpose(t.astype(jnp.float32), (0, 2, 1, 3)).reshape(B, H, N, C, dh)

    qc, kc, vc = to_chunks(q), to_chunks(k) * (dh ** -0.5), to_chunks(v)
    log_g = jnp.log(1.0 - jnp.exp2(-5.0 - jnp.arange(H, dtype=jnp.float32)))
    i = jnp.arange(C, dtype=jnp.float32)
    diff = i[:, None] - i[None, :]
    lower = diff >= 0
    dmat = jnp.where(lower[None], jnp.exp(jnp.where(lower, diff, 0.0)[None] * log_g[:, None, None]), 0.0)
    scores = jnp.einsum('bhnid,bhnjd->bhnij', qc, kc) * dmat[None, :, None]
    intra = jnp.einsum('bhnij,bhnje->bhnie', scores, vc)
    k_decay = jnp.exp((C - 1.0 - i)[None, :] * log_g[:, None])
    chunk_kv = jnp.einsum('bhncd,bhnce->bhnde', kc * k_decay[None, :, None, :, None], vc)
    chunk_decay = jnp.exp(C * log_g)[None, :, None, None]

    def step(state, kv):
        return state * chunk_decay + kv, state

    _, r_prev = lax.scan(step, jnp.zeros((B, H, dh, dh), jnp.float32), jnp.moveaxis(chunk_kv, 2, 0))
    r_prev = jnp.moveaxis(r_prev, 0, 2)
    q_decay = jnp.exp((i + 1.0)[None, :] * log_g[:, None])
    cross = jnp.einsum('bhncd,bhnde->bhnce', qc * q_decay[None, :, None, :, None], r_prev)
    out = (intra + cross).reshape(B, H, S, dh)
    return jnp.transpose(out, (0, 2, 1, 3))


def token_mixer(h, w_in, ret_gn_g, w_out, cos, sin):
    B, S, _ = h.shape
    u = h @ w_in
    cuts = [SB_WIDTH, 2 * SB_WIDTH, 3 * SB_WIDTH,
            3 * SB_WIDTH + RET_WIDTH, 3 * SB_WIDTH + 2 * RET_WIDTH, 3 * SB_WIDTH + 3 * RET_WIDTH]
    sbq, sbk, sbv, rq, rk, rv, rg = jnp.split(u, cuts, axis=-1)
    heads = lambda t, n: t.reshape(B, S, n, HEAD_DIM)
    sb = stick_breaking_attention(heads(sbq, SB_HEADS), heads(sbk, SB_HEADS), heads(sbv, SB_HEADS))
    ret = chunkwise_retention(apply_rope(heads(rq, RET_HEADS).astype(jnp.float32), cos, sin),
                              apply_rope(heads(rk, RET_HEADS).astype(jnp.float32), cos, sin),
                              heads(rv, RET_HEADS))
    ret = ret * lax.rsqrt(jnp.mean(ret * ret, axis=-1, keepdims=True) + EPS)
    ret = ret.reshape(B, S, RET_WIDTH) * ret_gn_g.astype(jnp.float32) * jax.nn.silu(rg.astype(jnp.float32))
    o = jnp.concatenate([sb.astype(h.dtype), ret.astype(h.dtype)], axis=-1)
    return o @ w_out


def moe_ffn(h2, w_router, router_bias, w_gate, w_up, w_down, ws_gate, ws_up, ws_down):
    T, D = h2.shape
    E = N_EXPERTS
    scores = jax.nn.sigmoid((h2 @ w_router).astype(jnp.float32))
    choice = scores + router_bias.astype(jnp.float32)
    grp = choice.reshape(T, N_GROUPS, E // N_GROUPS)
    grp_score = jnp.sum(lax.top_k(grp, 2)[0], axis=-1)
    _, gidx = lax.top_k(grp_score, TOPK_GROUP)
    gmask = jnp.any(gidx[..., None] == jnp.arange(N_GROUPS)[None, None, :], axis=1)
    emask = jnp.repeat(gmask, E // N_GROUPS, axis=1)
    _, eidx = lax.top_k(jnp.where(emask, choice, -jnp.inf), TOP_K)
    gsel = jnp.take_along_axis(scores, eidx, axis=1)
    gsel = gsel / jnp.sum(gsel, axis=-1, keepdims=True) * ROUTED_SCALE

    A = T * TOP_K
    flat_e = eidx.reshape(-1).astype(jnp.int32)
    flat_t = jnp.repeat(jnp.arange(T, dtype=jnp.int32), TOP_K)
    flat_w = gsel.reshape(-1)
    order = jnp.argsort(flat_e)
    se, st, sw = flat_e[order], flat_t[order], flat_w[order]
    counts = jax.ops.segment_sum(jnp.ones_like(flat_e), flat_e, num_segments=E)
    padded = ((counts + MOE_BLOCK - 1) // MOE_BLOCK) * MOE_BLOCK
    start = jnp.cumsum(counts) - counts
    pend = jnp.cumsum(padded)
    pstart = pend - padded
    pos = pstart[se] + (jnp.arange(A, dtype=jnp.int32) - start[se])
    P = A + E * MOE_BLOCK
    n_blk = P // MOE_BLOCK
    row_tok = jnp.full((P,), T, jnp.int32).at[pos].set(st)
    row_w = jnp.zeros((P,), jnp.float32).at[pos].set(sw)
    blk_expert = jnp.clip(jnp.searchsorted(pend, jnp.arange(n_blk, dtype=jnp.int32) * MOE_BLOCK, side='right'), 0, E - 1)
    h_pad = jnp.concatenate([h2, jnp.zeros((1, D), h2.dtype)], axis=0)

    def expert_block(y, xs):
        b, e = xs
        rows = lax.dynamic_slice(row_tok, (b * MOE_BLOCK,), (MOE_BLOCK,))
        gw = lax.dynamic_slice(row_w, (b * MOE_BLOCK,), (MOE_BLOCK,))
        xb = h_pad[rows]
        out = (jax.nn.silu(xb @ w_gate[e]) * (xb @ w_up[e])) @ w_down[e]
        return y.at[rows].add((out * gw[:, None]).astype(y.dtype)), None

    y, _ = lax.scan(expert_block, jnp.zeros((T + 1, D), h2.dtype),
                    (jnp.arange(n_blk, dtype=jnp.int32), blk_expert))
    shared = (jax.nn.silu(h2 @ ws_gate) * (h2 @ ws_up)) @ ws_down
    return y[:T] + shared


def setup_inputs(seed: int = 0) -> dict:
    key = jax.random.key(seed)
    ks = jax.random.split(key, 24)
    D, E, F, Fs = D_MODEL, N_EXPERTS, EXPERT_DIM, SHARED_DIM

    def nrm(k, shape, fan_in, scale=1.0):
        return jax.random.normal(k, shape, jnp.float32) * (scale * fan_in ** -0.5)

    def gain(k, shape):
        return 1.0 + 0.02 * jax.random.normal(k, shape, jnp.float32)

    return {
        'x': jax.random.normal(ks[0], (BATCH, SEQ, D), jnp.float32),
        'c': jax.random.normal(ks[1], (BATCH, D), jnp.float32),
        'w_ada': nrm(ks[2], (DEPTH, D, 6 * D), D, 0.5),
        'b_ada': 0.02 * jax.random.normal(ks[3], (DEPTH, 6 * D), jnp.float32),
        'norm1_g': gain(ks[4], (DEPTH, D)),
        'w_in': nrm(ks[5], (DEPTH, D, IN_COLS), D),
        'ret_gn_g': gain(ks[6], (DEPTH, RET_WIDTH)),
        'w_out': nrm(ks[7], (DEPTH, MIX_WIDTH, D), MIX_WIDTH),
        'norm2_g': gain(ks[8], (DEPTH, D)),
        'w_router': nrm(ks[9], (DEPTH, D, E), D),
        'router_bias': 0.01 * jax.random.normal(ks[10], (DEPTH, E), jnp.float32),
        'w_gate': nrm(ks[11], (DEPTH, E, D, F), D),
        'w_up': nrm(ks[12], (DEPTH, E, D, F), D),
        'w_down': nrm(ks[13], (DEPTH, E, F, D), F),
        'ws_gate': nrm(ks[14], (DEPTH, D, Fs), D),
        'ws_up': nrm(ks[15], (DEPTH, D, Fs), D),
        'ws_down': nrm(ks[16], (DEPTH, Fs, D), Fs),
        'w_ada_final': nrm(ks[17], (D, 2 * D), D, 0.5),
        'b_ada_final': 0.02 * jax.random.normal(ks[18], (2 * D,), jnp.float32),
        'norm_f_g': gain(ks[19], (D,)),
    }


def reference(x, c, w_ada, b_ada, norm1_g, w_in, ret_gn_g, w_out, norm2_g, w_router, router_bias,
              w_gate, w_up, w_down, ws_gate, ws_up, ws_down, w_ada_final, b_ada_final, norm_f_g):
    B, S, D = x.shape
    cos, sin = rope_tables(S)
    cs = jax.nn.silu(c)
    for l in range(DEPTH):
        mod = cs @ w_ada[l] + b_ada[l]
        sh1, sc1, g1, sh2, sc2, g2 = jnp.split(mod, 6, axis=-1)
        h = modulate(rmsnorm(x, norm1_g[l]), sh1, sc1)
        x = x + g1[:, None, :] * token_mixer(h, w_in[l], ret_gn_g[l], w_out[l], cos, sin)
        h = modulate(rmsnorm(x, norm2_g[l]), sh2, sc2)
        y = moe_ffn(h.reshape(B * S, D), w_router[l], router_bias[l], w_gate[l], w_up[l], w_down[l],
                    ws_gate[l], ws_up[l], ws_down[l])
        x = x + g2[:, None, :] * y.reshape(B, S, D)
    modf = cs @ w_ada_final + b_ada_final
    shf, scf = jnp.split(modf, 2, axis=-1)
    return modulate(rmsnorm(x, norm_f_g), shf, scf)
```

```cpp
#include <hip/hip_runtime.h>
#include <cstdio>
#include <cstdint>

#define GAS __attribute__((address_space(1)))
#define LAS __attribute__((address_space(3)))
typedef unsigned short bf16;
typedef float f32x2 __attribute__((ext_vector_type(2)));
typedef float f32x4 __attribute__((ext_vector_type(4)));
typedef float f32x16 __attribute__((ext_vector_type(16)));
typedef short bf16x8 __attribute__((ext_vector_type(8)));
typedef short s16x4 __attribute__((ext_vector_type(4)));
typedef unsigned u32x2 __attribute__((ext_vector_type(2)));
typedef unsigned u32x4 __attribute__((ext_vector_type(4)));
typedef int v8i_t __attribute__((ext_vector_type(8)));

constexpr int NB = 4, SEQ = 4096, T = NB * SEQ, D = 2048, HD = 128, NH = 8, INC = 7168, NE = 64, FE = 512, TOPK = 8;
constexpr float EPS = 1e-6f;
constexpr float LOG2E = 1.4426950408889634f;
constexpr float RSQ_HD = 0.08838834764831845f;
constexpr int NWAVES = 8, NTHR = 512;
#ifndef DUP_PHASE
#define DUP_PHASE -1
#endif
constexpr int NPH = 9;

constexpr size_t MiB = 1u << 20;
constexpr size_t WS_CTL = 0, CTL_ZERO_BYTES = 1 * MiB;
constexpr size_t WS_MOD = 1 * MiB;
constexpr size_t WS_META = WS_MOD + 512 * 1024;
constexpr size_t WS_ROPE = 2 * MiB;
constexpr size_t WS_LTOK = 4 * MiB;
constexpr size_t WS_LW = 8 * MiB;
constexpr size_t WS_WIN = 12 * MiB;
constexpr size_t WS_WOUT = 40 * MiB;
constexpr size_t WS_WD = 48 * MiB;
constexpr size_t WS_ACT = 178 * MiB;
constexpr size_t WS_BIG = 338 * MiB;
constexpr size_t WS_WGU = WS_BIG;
constexpr size_t WS_H1 = WS_BIG + 260 * MiB;
constexpr size_t WS_U = WS_BIG + 324 * MiB;
constexpr size_t WS_OUT = WS_BIG;
constexpr size_t WS_WR = WS_BIG + 576 * MiB;
constexpr size_t WS_END = WS_WR + 1 * MiB;
constexpr int SH_POS0 = 147456;
static_assert(WS_WGU + (size_t)65 * 1024 * 2048 * 2 <= WS_H1 && WS_H1 + (size_t)T * D * 2 <= WS_U && WS_U + (size_t)T * INC * 2 <= WS_WR, "ws map");
static_assert(WS_WD + (size_t)65 * 2048 * 512 * 2 <= WS_ACT && WS_ACT + (size_t)163840 * 512 * 2 <= WS_BIG && WS_OUT + (size_t)147456 * 2048 * 2 <= WS_WR, "ws map");
constexpr int CW_BAR = 1024, CW_QHEAD = 16384, CW_CNT = 8256, CW_CVQ = 20480;

constexpr int SCR_BYTES = 147456;
constexpr int LDSCTL_OFF = SCR_BYTES;
constexpr int STASH_OFF = SCR_BYTES + 1024;
constexpr int LDS_BYTES = STASH_OFF + 8192;

#define LDS_WAIT() asm volatile("s_waitcnt lgkmcnt(0)" ::: "memory")
#define VM_WAIT() asm volatile("s_waitcnt vmcnt(0)" ::: "memory")
#define SBAR() __builtin_amdgcn_sched_barrier(0)
typedef __bf16 bf16x2_t __attribute__((ext_vector_type(2)));
__device__ __forceinline__ unsigned cvtpk(float lo, float hi) { const f32x2 v = {lo, hi}; const bf16x2_t r = __builtin_convertvector(v, bf16x2_t); return __builtin_bit_cast(unsigned, r); }
__device__ __forceinline__ unsigned pk_fp8x4(float a, float b, float c, float d) { int w = 0; w = __builtin_amdgcn_cvt_pk_fp8_f32(a, b, w, false); w = __builtin_amdgcn_cvt_pk_fp8_f32(c, d, w, true); return (unsigned)w; }
__device__ __forceinline__ float bf2f(unsigned short b) { return __uint_as_float(((unsigned)b) << 16); }
__device__ __forceinline__ float bflo(unsigned w) { return __uint_as_float(w << 16); }
__device__ __forceinline__ float bfhi(unsigned w) { return __uint_as_float(w & 0xffff0000u); }
__device__ __forceinline__ float wave_sum(float v) {
#pragma unroll
    for (int o = 1; o < 64; o <<= 1) v += __shfl_xor(v, o);
    return v;
}
__device__ __forceinline__ int lane_now() { int l; asm volatile("v_mbcnt_lo_u32_b32 %0, -1, 0\n\tv_mbcnt_hi_u32_b32 %0, -1, %0" : "=v"(l)); return l; }
#define TIDX (g_wv * 64 + lane_now())
__device__ __forceinline__ float fast_rcp(float x) { return __builtin_amdgcn_rcpf(x); }
__device__ __forceinline__ float fast_exp2(float x) { return __builtin_amdgcn_exp2f(x); }
__device__ __forceinline__ float silu_f(float x) { return x * fast_rcp(1.0f + fast_exp2(-x * LOG2E)); }

#define XB_TMO      128
#define XB_XCNT(j)  (256  + 64 * (j))
#define XB_XSUB(j)  (1280 + 64 * (j))
#define XB_XGEN(j)  (2304 + 64 * (j))
#define XB_TOP      3328
#define XB_TOPGEN   3392
#define XCD_BAR_WORDS 3456
#define XB_SPIN_CAP (1u << 18)
__device__ __forceinline__ unsigned xb_ld(unsigned* p)              { return __hip_atomic_load(p, __ATOMIC_RELAXED, __HIP_MEMORY_SCOPE_AGENT); }
__device__ __forceinline__ unsigned xb_add(unsigned* p, unsigned v) { return __hip_atomic_fetch_add(p, v, __ATOMIC_RELAXED, __HIP_MEMORY_SCOPE_AGENT); }
__device__ __forceinline__ unsigned xb_xcc_id() { return (unsigned)__builtin_amdgcn_s_getreg((3 << 11) | 20) & 0xFu; }
#define XB_SPIN(cond, bar) do { unsigned _sp = 0; while (cond) { __builtin_amdgcn_s_sleep(1); \
    if ((++_sp & 255u) == 0u) { if (xb_ld(&(bar)[XB_TMO])) break; if (_sp > XB_SPIN_CAP) { atomicAdd(&(bar)[XB_TMO], 1u); break; } } } } while (0)
struct XcdBarrier { unsigned* bar; unsigned x; volatile LAS unsigned* st; };
__device__ __forceinline__ XcdBarrier xcd_barrier_post(unsigned* bar, volatile LAS unsigned* st, const int g_wv) {
    XcdBarrier b; b.bar = bar; b.x = xb_xcc_id(); b.st = st;
    if (TIDX == 0) (void)xb_add(&bar[XB_XCNT(b.x)], 1u);
    return b;
}
__device__ __forceinline__ void xcd_barrier_complete(unsigned* bar, unsigned x, unsigned& nloc, unsigned& nx) {
    const unsigned G = gridDim.x * gridDim.y * gridDim.z;
    unsigned sum, cnt, mine, sp = 0u;
    for (;;) {
        sum = 0u; cnt = 0u; mine = 0u;
#pragma unroll
        for (unsigned j = 0; j < 16; ++j) { const unsigned c = xb_ld(&bar[XB_XCNT(j)]); sum += c; cnt += (c > 0u) ? 1u : 0u; mine = (j == x) ? c : mine; }
        if (sum == G) break;
        __builtin_amdgcn_s_sleep(1);
        if ((++sp & 255u) == 0u) { if (xb_ld(&bar[XB_TMO])) break; if (sp > XB_SPIN_CAP) { atomicAdd(&bar[XB_TMO], 1u); break; } }
    }
    nloc = mine > 0u ? mine : 1u; nx = cnt > 0u ? cnt : 1u;
}
__device__ __forceinline__ void xcd_barrier(const XcdBarrier& b, const int g_wv) {
    asm volatile("s_waitcnt vmcnt(0)" ::: "memory");
    __syncthreads();
    if (TIDX == 0) {
        unsigned* bar = b.bar;
        __builtin_amdgcn_s_waitcnt(0);
        unsigned nloc = b.st[0], nx = b.st[1];
        if (nloc == 0u) { xcd_barrier_complete(bar, b.x, nloc, nx); b.st[0] = nloc; b.st[1] = nx; }
        const unsigned old = xb_add(&bar[XB_XSUB(b.x)], 1u);
        const unsigned gen = old / nloc;
        if (old + 1u == (gen + 1u) * nloc) {
            __builtin_amdgcn_fence(__ATOMIC_RELEASE, "agent");
            asm volatile("s_waitcnt vmcnt(0)" ::: "memory");
            const unsigned og = xb_add(&bar[XB_TOP], 1u);
            const unsigned tg = og / nx;
            if (og + 1u == (tg + 1u) * nx) xb_add(&bar[XB_TOPGEN], 1u);
            else XB_SPIN(xb_ld(&bar[XB_TOPGEN]) == tg, bar);
            __builtin_amdgcn_fence(__ATOMIC_ACQUIRE, "agent");
            xb_add(&bar[XB_XGEN(b.x)], 1u);
            asm volatile("s_waitcnt vmcnt(0)" ::: "memory");
        } else {
            XB_SPIN(xb_ld(&bar[XB_XGEN(b.x)]) == gen, bar);
            __builtin_amdgcn_fence(__ATOMIC_ACQUIRE, "agent");
            asm volatile("s_waitcnt vmcnt(0)" ::: "memory");
        }
    }
    __syncthreads();
}

struct Args { const float* in[20]; float* out; unsigned char* ws; int ph_lo, ph_hi; };
enum { I_X = 0, I_C, I_WADA, I_BADA, I_N1G, I_WIN, I_RGN, I_WOUT, I_N2G, I_WR, I_RB, I_WG, I_WU, I_WDN, I_SG, I_SU, I_SD, I_WAF, I_BAF, I_NFG };

__constant__ float c_inv_freq[64] = {
1.0f, 0.865964353f, 0.749894202f, 0.649381638f, 0.562341332f, 0.486967534f, 0.421696514f, 0.365174115f, 0.316227764f, 0.273841977f, 0.237137377f, 0.2053525f, 0.177827939f, 0.153992653f, 0.133352146f, 0.115478195f,
0.100000001f, 0.0865964293f, 0.0749894232f, 0.0649381652f, 0.0562341325f, 0.0486967526f, 0.0421696492f, 0.0365174115f, 0.0316227749f, 0.0273841955f, 0.0237137377f, 0.0205352511f, 0.0177827943f, 0.0153992651f, 0.013335214f, 0.0115478197f,
0.00999999978f, 0.00865964312f, 0.00749894232f, 0.00649381615f, 0.00562341325f, 0.00486967526f, 0.00421696482f, 0.00365174119f, 0.00316227763f, 0.00273841969f, 0.00237137382f, 0.00205352507f, 0.00177827943f, 0.00153992651f, 0.00133352145f, 0.00115478202f,
0.00100000005f, 0.000865964335f, 0.000749894185f, 0.000649381604f, 0.000562341302f, 0.000486967532f, 0.000421696517f, 0.000365174114f, 0.000316227757f, 0.000273841957f, 0.00023713737f, 0.00020535251f, 0.00017782794f, 0.00015399266f, 0.00013335215f, 0.0001154782f };

template <int MODE> __device__ __forceinline__ int cvt_orow(int n) {
    if (MODE == 1) { const int grp = n >> 10; if (grp == 3 || grp == 4) { const int d = n & 127; return (n & ~127) + 2 * (d & 63) + (d >> 6); } return n; }
    if (MODE == 2) return ((n >> 7) << 8) + (n & 127);
    if (MODE == 3) return ((n >> 7) << 8) + 128 + (n & 127);
    return n;
}
template <int MODE> __device__ __forceinline__ void cvt_item(const float* W, int ldw, int k0, int n0, bf16* dst, int ldd, LAS float* scr, int lane) {
    const int n4 = lane & 15, kr = lane >> 4;
    f32x4 v[16];
#pragma unroll
    for (int i = 0; i < 16; ++i) v[i] = __builtin_nontemporal_load((const GAS f32x4*)(W + (size_t)(k0 + 4 * i + kr) * ldw + n0 + 4 * n4));
#pragma unroll
    for (int i = 0; i < 16; ++i) { LAS float* s = scr + (4 * i + kr) * 65 + 4 * n4; s[0] = v[i].x; s[1] = v[i].y; s[2] = v[i].z; s[3] = v[i].w; }
    LDS_WAIT(); asm volatile("" ::: "memory");
    const int kg = lane & 7, ns = lane >> 3;
#pragma unroll
    for (int j = 0; j < 8; ++j) { const int n = ns + 8 * j; const LAS float* s = scr + (8 * kg) * 65 + n;
        u32x4 o; o.x = cvtpk(s[0], s[65]); o.y = cvtpk(s[2 * 65], s[3 * 65]); o.z = cvtpk(s[4 * 65], s[5 * 65]); o.w = cvtpk(s[6 * 65], s[7 * 65]);
        *(GAS u32x4*)(dst + (size_t)cvt_orow<MODE>(n0 + n) * ldd + k0 + 8 * kg) = o; }
    LDS_WAIT(); asm volatile("" ::: "memory");
}
constexpr int CV_I0 = 32 * 112, CV_I1 = 32 * 32, CV_I2 = 64 * 32 * 8, CV_I4 = 64 * 8 * 32, CV_I5 = 32 * 8, CV_I7 = 8 * 32;
constexpr int CV_EARLY = CV_I0 + CV_I1, CV_SPLIT = CV_I0 + CV_I1 + 2 * CV_I2, CV_NIT = CV_I0 + CV_I1 + 2 * CV_I2 + CV_I4 + 2 * CV_I5 + CV_I7;
constexpr float WSCALE = 64.0f, ASCALE = 16.0f;
template <bool F8>
__device__ __forceinline__ void cvt_run(unsigned char* ws, LAS unsigned char* lds, const int g_wv, const int lo, const int hi, const int wg_local = 0) {
    const int tid = TIDX, lane = tid & 63, wave = g_wv, G = gridDim.x, bx = blockIdx.x;
    const volatile LAS unsigned long long* ptab = (const volatile LAS unsigned long long*)(lds + LDSCTL_OFF + 256);
    {
        LAS float* scr = (LAS float*)(lds + wave * 16640);
        const int gw = wg_local ? wave : bx * NWAVES + wave, NGW = wg_local ? NWAVES : G * NWAVES;
        bf16* Win = (bf16*)(ws + WS_WIN); bf16* Wout = (bf16*)(ws + WS_WOUT); unsigned char* Wgu8 = ws + WS_WGU; unsigned char* Wd8 = ws + WS_WD;
        constexpr int I0 = CV_I0, I1 = CV_I1, I2 = CV_I2, I4 = CV_I4, I5 = CV_I5; const int NIT = hi;
#define CVT_PTR(i_) ((const float*)(uintptr_t)ptab[i_])
#define CVT_DEC(it_, W_, dst_, ldw_, ldd_, k0_, n0_, mode_) do { int r = (it_); \
            if (r < I0) { W_ = CVT_PTR(0); ldw_ = INC; k0_ = 64 * (r / 112); n0_ = 64 * (r % 112); dst_ = Win; ldd_ = D; mode_ = 1; } \
            else if ((r -= I0) < I1) { W_ = CVT_PTR(1); ldw_ = D; k0_ = 64 * (r / 32); n0_ = 64 * (r % 32); dst_ = Wout; ldd_ = D; mode_ = 0; } \
            else if ((r -= I1) < I2) { const int e = r >> 8, q = r & 255; W_ = CVT_PTR(2) + (size_t)e * D * FE; ldw_ = FE; k0_ = 64 * (q >> 3); n0_ = 64 * (q & 7); dst_ = (bf16*)(Wgu8 + (size_t)e * 1024 * D); ldd_ = D; mode_ = 2; } \
            else if ((r -= I2) < I2) { const int e = r >> 8, q = r & 255; W_ = CVT_PTR(3) + (size_t)e * D * FE; ldw_ = FE; k0_ = 64 * (q >> 3); n0_ = 64 * (q & 7); dst_ = (bf16*)(Wgu8 + (size_t)e * 1024 * D); ldd_ = D; mode_ = 3; } \
            else if ((r -= I2) < I4) { const int e = r >> 8, q = r & 255; W_ = CVT_PTR(4) + (size_t)e * FE * D; ldw_ = D; k0_ = 64 * (q >> 5); n0_ = 64 * (q & 31); dst_ = (bf16*)(Wd8 + (size_t)e * D * FE); ldd_ = FE; mode_ = 0; } \
            else if ((r -= I4) < I5) { W_ = CVT_PTR(5); ldw_ = FE; k0_ = 64 * (r >> 3); n0_ = 64 * (r & 7); dst_ = (bf16*)(Wgu8 + (size_t)64 * 1024 * D); ldd_ = D; mode_ = 2; } \
            else if ((r -= I5) < I5) { W_ = CVT_PTR(6); ldw_ = FE; k0_ = 64 * (r >> 3); n0_ = 64 * (r & 7); dst_ = (bf16*)(Wgu8 + (size_t)64 * 1024 * D); ldd_ = D; mode_ = 3; } \
            else { r -= I5; W_ = CVT_PTR(7); ldw_ = D; k0_ = 64 * (r >> 5); n0_ = 64 * (r & 31); dst_ = (bf16*)(Wd8 + (size_t)64 * D * FE); ldd_ = FE; mode_ = 0; } } while (0)
        const int n4 = lane & 15, kr = lane >> 4, kg = lane & 7, ns = lane >> 3;
#define CVT_LOAD(V_, W_, ldw_, k0_, n0_) do { _Pragma("unroll") for (int i = 0; i < 16; ++i) V_[i] = __builtin_nontemporal_load((const GAS f32x4*)((W_) + (size_t)((k0_) + (F8 ? 16 * (i >> 2) + 4 * kr + (i & 3) : 8 * (i >> 1) + 2 * kr + (i & 1))) * (ldw_) + (n0_) + 4 * n4)); } while (0)
#define CVT_STORE(V_, dst_, ldd_, k0_, n0_, mode_) do { LAS unsigned* s32 = (LAS unsigned*)scr; \
            if constexpr (F8) { \
            _Pragma("unroll") for (int j = 0; j < 4; ++j) { LAS unsigned* s = s32 + (4 * n4) * 17 + 4 * j + kr; \
                s[0] = pk_fp8x4(V_[4 * j].x * WSCALE, V_[4 * j + 1].x * WSCALE, V_[4 * j + 2].x * WSCALE, V_[4 * j + 3].x * WSCALE); s[17] = pk_fp8x4(V_[4 * j].y * WSCALE, V_[4 * j + 1].y * WSCALE, V_[4 * j + 2].y * WSCALE, V_[4 * j + 3].y * WSCALE); \
                s[34] = pk_fp8x4(V_[4 * j].z * WSCALE, V_[4 * j + 1].z * WSCALE, V_[4 * j + 2].z * WSCALE, V_[4 * j + 3].z * WSCALE); s[51] = pk_fp8x4(V_[4 * j].w * WSCALE, V_[4 * j + 1].w * WSCALE, V_[4 * j + 2].w * WSCALE, V_[4 * j + 3].w * WSCALE); } \
            LDS_WAIT(); asm volatile("" ::: "memory"); \
            _Pragma("unroll") for (int j = 0; j < 4; ++j) { const int n = (n0_) + (lane >> 2) + 16 * j; const LAS unsigned* s = s32 + ((lane >> 2) + 16 * j) * 17 + 4 * (lane & 3); \
                int orow = n; if ((mode_) == 1) { const int grp = n >> 10; if (grp == 3 || grp == 4) { const int dd = n & 127; orow = (n & ~127) + 2 * (dd & 63) + (dd >> 6); } } \
                else if ((mode_) >= 2) orow = ((n >> 7) << 8) + (n & 127) + ((mode_) == 3 ? 128 : 0); \
                u32x4 o; o.x = s[0]; o.y = s[1]; o.z = s[2]; o.w = s[3]; \
                __builtin_nontemporal_store(o, (GAS u32x4*)((unsigned char*)(dst_) + (size_t)orow * (ldd_) + (k0_) + 16 * (lane & 3))); } \
            } else { \
            _Pragma("unroll") for (int j = 0; j < 8; ++j) { LAS unsigned* s = s32 + (4 * n4) * 33 + 4 * j + kr; \
                s[0] = cvtpk(V_[2 * j].x, V_[2 * j + 1].x); s[33] = cvtpk(V_[2 * j].y, V_[2 * j + 1].y); s[66] = cvtpk(V_[2 * j].z, V_[2 * j + 1].z); s[99] = cvtpk(V_[2 * j].w, V_[2 * j + 1].w); } \
            LDS_WAIT(); asm volatile("" ::: "memory"); \
            _Pragma("unroll") for (int j = 0; j < 8; ++j) { const int n = (n0_) + ns + 8 * j; const LAS unsigned* s = s32 + (ns + 8 * j) * 33 + 4 * kg; \
                int orow = n; if ((mode_) == 1) { const int grp = n >> 10; if (grp == 3 || grp == 4) { const int dd = n & 127; orow = (n & ~127) + 2 * (dd & 63) + (dd >> 6); } } \
                else if ((mode_) >= 2) orow = ((n >> 7) << 8) + (n & 127) + ((mode_) == 3 ? 128 : 0); \
                u32x4 o; o.x = s[0]; o.y = s[1]; o.z = s[2]; o.w = s[3]; \
                __builtin_nontemporal_store(o, (GAS u32x4*)((dst_) + (size_t)orow * (ldd_) + (k0_) + 8 * kg)); } \
            } \
            LDS_WAIT(); asm volatile("" ::: "memory"); } while (0)
        f32x4 va[16], vb[16];
#define CVT_L(V_, it_) do { const float* W_ = nullptr; bf16* ds_ = nullptr; int lw_ = 0, ld_ = 0, k_ = 0, n_ = 0, mo_ = 0; CVT_DEC(it_, W_, ds_, lw_, ld_, k_, n_, mo_); (void)ds_; (void)ld_; (void)mo_; CVT_LOAD(V_, W_, lw_, k_, n_); } while (0)
#define CVT_S(V_, it_) do { const float* W_ = nullptr; bf16* ds_ = nullptr; int lw_ = 0, ld_ = 0, k_ = 0, n_ = 0, mo_ = 0; CVT_DEC(it_, W_, ds_, lw_, ld_, k_, n_, mo_); (void)W_; (void)lw_; CVT_STORE(V_, ds_, ld_, k_, n_, mo_); } while (0)
        f32x4 vc[16];
        int it = lo + gw;
        if (it < NIT) { CVT_L(va, it); if (it + NGW < NIT) CVT_L(vb, it + NGW);
            for (;;) {
                if (it + 2 * NGW < NIT) CVT_L(vc, it + 2 * NGW);
                CVT_S(va, it); it += NGW; if (it >= NIT) break;
                if (it + 2 * NGW < NIT) CVT_L(va, it + 2 * NGW);
                CVT_S(vb, it); it += NGW; if (it >= NIT) break;
                if (it + 2 * NGW < NIT) CVT_L(vb, it + 2 * NGW);
                CVT_S(vc, it); it += NGW; if (it >= NIT) break;
            }
        }
#undef CVT_L
#undef CVT_S
#undef CVT_DEC
#undef CVT_PTR
#undef CVT_LOAD
#undef CVT_STORE
    }
}

__device__ __forceinline__ void p0_prologue(const Args& a, LAS unsigned char* lds, const int g_wv) {
    const int tid = TIDX, lane = tid & 63, wave = g_wv, G = gridDim.x, bx = blockIdx.x;
    unsigned char* ws = a.ws;
    float* modv = (float*)(ws + WS_MOD);
    {
        LAS float* cs = (LAS float*)lds;
        LAS float* red = (LAS float*)(lds + 32768);
        for (int i = tid; i < 4 * D; i += NTHR) cs[i] = silu_f(a.in[I_C][i]);
        __syncthreads();
        for (int it = bx; it < 256; it += G) {
            const float* W; int ldw, col; const float* bias;
            if (it < 192) { W = a.in[I_WADA]; ldw = 6 * D; col = it * 64; bias = a.in[I_BADA]; }
            else { W = a.in[I_WAF]; ldw = 2 * D; col = (it - 192) * 64; bias = a.in[I_BAF]; }
            float a0 = 0.f, a1 = 0.f, a2 = 0.f, a3 = 0.f;
            const int kbeg = wave * 256;
#pragma unroll 16
            for (int k4 = 0; k4 < 64; ++k4) {
                const int k = kbeg + 4 * k4;
                float wv[4];
#pragma unroll
                for (int c = 0; c < 4; ++c) wv[c] = __builtin_nontemporal_load(W + (size_t)(k + c) * ldw + col + lane);
                const f32x4 c0 = *(const LAS f32x4*)(cs + k), c1 = *(const LAS f32x4*)(cs + D + k), c2 = *(const LAS f32x4*)(cs + 2 * D + k), c3 = *(const LAS f32x4*)(cs + 3 * D + k);
                a0 += c0.x * wv[0] + c0.y * wv[1] + c0.z * wv[2] + c0.w * wv[3];
                a1 += c1.x * wv[0] + c1.y * wv[1] + c1.z * wv[2] + c1.w * wv[3];
                a2 += c2.x * wv[0] + c2.y * wv[1] + c2.z * wv[2] + c2.w * wv[3];
                a3 += c3.x * wv[0] + c3.y * wv[1] + c3.z * wv[2] + c3.w * wv[3];
            }
            red[(wave * 4 + 0) * 64 + lane] = a0; red[(wave * 4 + 1) * 64 + lane] = a1; red[(wave * 4 + 2) * 64 + lane] = a2; red[(wave * 4 + 3) * 64 + lane] = a3;
            __syncthreads();
            if (tid < 256) { const int b = tid >> 6; float s = bias[col + lane];
#pragma unroll
                for (int w = 0; w < 8; ++w) s += red[(w * 4 + b) * 64 + lane];
                modv[b * 16384 + it * 64 + lane] = s; }
            __syncthreads();
        }
    }
    {
        float* rope = (float*)(ws + WS_ROPE);
        for (int i = bx * NTHR + tid; i < SEQ * 64; i += G * NTHR) {
            const int pos = i >> 6, f = i & 63;
            const double rev = (double)pos * (double)c_inv_freq[f] * 0.15915494309189533577;
            const float fr = (float)(rev - __builtin_rint(rev));
            f32x2 o; o.x = __builtin_amdgcn_cosf(fr); o.y = __builtin_amdgcn_sinf(fr);
            *(GAS f32x2*)(rope + 2 * (size_t)i) = o;
        }
    }
    {
        bf16* Wrh = (bf16*)(ws + WS_WR); bf16* Wrl = Wrh + NE * D;
        for (int i = bx * NTHR + tid; i < NE * (D / 8); i += G * NTHR) {
            const int ln = i & 63, nt = (i >> 6) & 3, ks = i >> 8;
            const int e = nt * 16 + (ln & 15), k0 = 32 * ks + 8 * (ln >> 4); float v[8];
#pragma unroll
            for (int j = 0; j < 8; ++j) v[j] = a.in[I_WR][(size_t)(k0 + j) * NE + e];
            u32x4 hw, lw;
#pragma unroll
            for (int j = 0; j < 4; ++j) { const unsigned hp = cvtpk(v[2 * j], v[2 * j + 1]); ((unsigned*)&hw)[j] = hp; ((unsigned*)&lw)[j] = cvtpk(v[2 * j] - bflo(hp), v[2 * j + 1] - bfhi(hp)); }
            *(GAS u32x4*)(Wrh + (size_t)i * 8) = hw; *(GAS u32x4*)(Wrl + (size_t)i * 8) = lw;
        }
    }
    cvt_run<true>(a.ws, lds, g_wv, 0, CV_EARLY);
}

template <bool F8>
__device__ __forceinline__ void norm_rows_bf16(const float* X, const float* gain, const float* modv, int off_shift, int off_scale, bf16* Hout, const int g_wv) {
    const int tid = TIDX, lane = tid & 63, wave = g_wv;
    const int gw = blockIdx.x * NWAVES + wave, NGW = gridDim.x * NWAVES;
    f32x4 A[8], B[8]; int curb = -1;
    for (int row = (int)((long)gw * T / NGW), rowe = (int)((long)(gw + 1) * T / NGW); row < rowe; ++row) {
        const int b = row >> 12;
        if (b != curb) { curb = b;
#pragma unroll
            for (int j = 0; j < 8; ++j) { const int d = 4 * lane + 256 * j; const f32x4 g = *(const GAS f32x4*)(gain + d), sc = *(const GAS f32x4*)(modv + b * 16384 + off_scale + d);
                A[j] = g * (1.0f + sc); B[j] = *(const GAS f32x4*)(modv + b * 16384 + off_shift + d); } }
        const GAS f32x4* xr = (const GAS f32x4*)(X + (size_t)row * D) + lane;
        f32x4 v[8]; float ss = 0.f;
#pragma unroll
        for (int j = 0; j < 8; ++j) { v[j] = __builtin_nontemporal_load(xr + 64 * j); ss += (v[j].x * v[j].x + v[j].y * v[j].y) + (v[j].z * v[j].z + v[j].w * v[j].w); }
        const float rstd = __builtin_amdgcn_rsqf(wave_sum(ss) * (1.0f / D) + EPS);
        if constexpr (F8) { GAS unsigned* o4 = (GAS unsigned*)((unsigned char*)Hout + (size_t)row * D) + lane;
#pragma unroll
            for (int j = 0; j < 8; ++j) { const f32x4 h = v[j] * rstd * A[j] + B[j]; o4[64 * j] = pk_fp8x4(h.x, h.y, h.z, h.w); }
        } else { GAS u32x2* o8 = (GAS u32x2*)(Hout + (size_t)row * D) + lane;
#pragma unroll
            for (int j = 0; j < 8; ++j) { const f32x4 h = v[j] * rstd * A[j] + B[j]; u32x2 w; w.x = cvtpk(h.x, h.y); w.y = cvtpk(h.z, h.w); o8[64 * j] = w; } }
    }
}

namespace pg8 {
constexpr int BM = 256, BK = 64, HALF = 128, HTB = HALF * BK * 2, STAGE_BYTES = 8 * HTB, NXCD = 8, WGM = 8;
__host__ __device__ __forceinline__ int lds_byte(int r, int c) { const int st = (r >> 4) * 2 + (c >> 5), rr = r & 15, cc = c & 31, ob = rr * 64 + cc * 2; return st * 1024 + (ob ^ (((ob >> 9) & 1) << 5)); }
__host__ __device__ __forceinline__ void stage_rc(int b, int& R, int& C) { const int st = b / 1024, sb = b % 1024, swz = sb ^ (((sb >> 9) & 1) << 5); R = (st >> 1) * 16 + swz / 64; C = (st & 1) * 32 + (swz % 64) / 2; }
__host__ __device__ __forceinline__ int perm32(int rho) { const int n = rho >> 4, i = rho & 15; return 8 * (i >> 2) + 4 * n + (i & 3); }

struct DUnit { int pm, pn; };
struct DenseOrder {
    typedef DUnit Unit;
    int nM, nN, nwg, G, c, K, i0, cnt;
    __device__ void init(int M, int N, int K_, int G_, int c_) { nM = M / BM; nN = N / BM; nwg = nM * nN; G = G_; c = c_; K = K_; i0 = 0; cnt = 1 << 30; }
    __device__ bool next(int i, DUnit& u) const {
        if (i >= cnt) return false;
        const long L = (long)(i + i0) * G + c; if (L >= nwg) return false;
        int wgid = (int)L; { const int q = nwg / NXCD, r = nwg % NXCD, xcd = wgid % NXCD, off = wgid / NXCD; wgid = (xcd < r ? xcd * (q + 1) : r * (q + 1) + (xcd - r) * q) + off; }
        const int nig = WGM * nN, gid = wgid / nig, fm = gid * WGM, gsz = (nM - fm) < WGM ? (nM - fm) : WGM;
        u.pm = fm + ((wgid % nig) % gsz); u.pn = (wgid % nig) / gsz; return true;
    }
    __device__ __forceinline__ void a_offs(const DUnit& u, int tid, unsigned (&ao)[2][2]) const {
#pragma unroll
        for (int i = 0; i < 2; ++i) { int R, C; stage_rc(tid * 16 + i * 8192, R, C);
#pragma unroll
            for (int h = 0; h < 2; ++h) ao[h][i] = (unsigned)(((u.pm * BM + h * HALF + R) * K + C) * 2); }
    }
    __device__ __forceinline__ size_t b_off(const DUnit& u) const { return (size_t)u.pn * BM * K * 2; }
    static constexpr bool LANE_CONST = true;
    __device__ __forceinline__ unsigned a_base(const DUnit& u) const { return (unsigned)u.pm * (unsigned)(BM * K * 2); }
    __device__ __forceinline__ void a_lane(int tid, unsigned (&vo)[2]) const {
#pragma unroll
        for (int i = 0; i < 2; ++i) { int R, C; stage_rc(tid * 16 + i * 8192, R, C); vo[i] = (unsigned)((R * K + C) * 2); }
    }
};

typedef int v4i_t __attribute__((ext_vector_type(4)));
template <bool F8> struct FragT { struct T { bf16x8 kh[2]; }; };
template <> struct FragT<true> { struct T { v8i_t v; }; };
template <class Sched, class Epi, bool ALIGN_EPI, bool SP2, int PROBE = 0>
__device__ __forceinline__ void gemm_phase(LAS unsigned char* lds, const char* gA, const char* gB, const int K, const Sched& S, const Epi& E, const int g_wv) {
    static_assert(SP2, "only the two-phase-per-half schedule is kept");
    const int tid = TIDX, wid = g_wv, lane = tid & 63, wr = wid >> 2, wc = wid & 3, fr = lane & 15, fq = lane >> 4;
    const int nt = K / BK;
    constexpr bool LEAN = Epi::FP8, LANEC = LEAN && Sched::LANE_CONST, STASH = LEAN && !Sched::LANE_CONST;
    unsigned voffB[2];
#pragma unroll
    for (int i = 0; i < 2; ++i) { int R, C; stage_rc(tid * 16 + i * 8192, R, C);
        const int Rb = (Epi::PERM == 1) ? ((R & ~31) + perm32(R & 31)) : (Epi::PERM == 3) ? (64 * (R >> 5) + 16 * ((R >> 2) & 3) + 4 * ((R >> 4) & 1) + (R & 3)) : R;
        voffB[i] = (unsigned)(Rb * K + C) * 2u; }
    const size_t hstepB = (Epi::PERM == 3) ? (size_t)8 * K * 2 : (size_t)HALF * K * 2;
    const size_t kstep = (size_t)(BK * 2);
    const size_t hstep = (size_t)HALF * K * 2;
    const unsigned ldsw = (unsigned)wid * 1024u;
    const int aoff = lds_byte(wr * 64 + fr, fq * 8), boff = lds_byte(wc * 32 + fr, fq * 8);
#define PG8_SA(b, h) (((b) * 2 + (h)) * HTB)
#define PG8_SB(b, h) ((4 + (b) * 2 + (h)) * HTB)
#define PG8_STAGE_B(bufoff, gbase, h) do { const char* _bb = (const char*)(gbase) + (h) * hstepB; unsigned _lb = ldsw; asm volatile("" : "+s"(_bb), "+s"(_lb)); _Pragma("unroll") for (int _i = 0; _i < 2; ++_i) { \
        unsigned _o = voffB[_i]; asm volatile("" : "+v"(_o)); \
        __builtin_amdgcn_global_load_lds((const unsigned*)(_bb + _o), (LAS unsigned*)(lds + (bufoff) + _lb + _i * 8192), 16, 0, 0); } } while (0)
#define PG8_STAGE_A(bufoff, kb, AO, ABASE, h) do { const char* _ab = gA + (size_t)(kb) + (LANEC ? (ABASE) + (h) * hstep : (size_t)0); unsigned _lb = ldsw; asm volatile("" : "+s"(_ab), "+s"(_lb)); _Pragma("unroll") for (int _i = 0; _i < 2; ++_i) { \
        unsigned _o = LANEC ? voffA[_i] : (AO)[h][_i]; asm volatile("" : "+v"(_o)); \
        __builtin_amdgcn_global_load_lds((const unsigned*)(_ab + _o), (LAS unsigned*)(lds + (bufoff) + _lb + _i * 8192), 16, 0, 0); } } while (0)
#define PG8_LDA(dst, b, h) do { if constexpr (PROBE != 2) _Pragma("unroll") for (int m = 0; m < 4; ++m) { if constexpr (Epi::FP8) { { const v4i_t _lo = *(const LAS v4i_t*)(lds + PG8_SA(b, h) + aoff + m * 2048), _hi = *(const LAS v4i_t*)(lds + PG8_SA(b, h) + aoff + m * 2048 + 1024); dst[m].v = __builtin_shufflevector(_lo, _hi, 0, 1, 2, 3, 4, 5, 6, 7); } } \
        else { _Pragma("unroll") for (int k = 0; k < 2; ++k) dst[m].kh[k] = *(const LAS bf16x8*)(lds + PG8_SA(b, h) + aoff + m * 2048 + k * 1024); } } } while (0)
#define PG8_LDB(dst, b, h) do { if constexpr (PROBE != 2) _Pragma("unroll") for (int n = 0; n < 2; ++n) { if constexpr (Epi::FP8) { { const v4i_t _lo = *(const LAS v4i_t*)(lds + PG8_SB(b, h) + boff + n * 2048), _hi = *(const LAS v4i_t*)(lds + PG8_SB(b, h) + boff + n * 2048 + 1024); dst[n].v = __builtin_shufflevector(_lo, _hi, 0, 1, 2, 3, 4, 5, 6, 7); } } \
        else { _Pragma("unroll") for (int k = 0; k < 2; ++k) dst[n].kh[k] = *(const LAS bf16x8*)(lds + PG8_SB(b, h) + boff + n * 2048 + k * 1024); } } } while (0)
#define PG8_MMA(ai, bj, At, Bt) do { __builtin_amdgcn_s_setprio(1); if constexpr (PROBE != 1) _Pragma("unroll") for (int m = 0; m < 4; ++m) _Pragma("unroll") for (int n = 0; n < 2; ++n) { \
        if constexpr (Epi::FP8) acc[ai][bj][m][n] = __builtin_amdgcn_mfma_scale_f32_16x16x128_f8f6f4(Bt[n].v, At[m].v, acc[ai][bj][m][n], 0, 0, 0, 0, 0, 0); \
        else { _Pragma("unroll") for (int k = 0; k < 2; ++k) acc[ai][bj][m][n] = __builtin_amdgcn_mfma_f32_16x16x32_bf16(Bt[n].kh[k], At[m].kh[k], acc[ai][bj][m][n], 0, 0, 0); } } \
        _Pragma("unroll") for (int m = 0; m < 4; ++m) asm volatile("" : "+v"(acc[ai][bj][m][0]), "+v"(acc[ai][bj][m][1]));     \
        __builtin_amdgcn_s_setprio(0); } while (0)
#define PG8_WAIT_V(n) asm volatile("s_waitcnt vmcnt(" #n ")" ::: "memory")
#define PG8_WAIT_L(n) asm volatile("s_waitcnt lgkmcnt(" #n ")" ::: "memory")
#define PG8_BAR __builtin_amdgcn_s_barrier()
#define PG8_SCHED __builtin_amdgcn_sched_barrier(0)
#define PG8_STEP(KK1, KK2, KK3, PB2, PB3, AO2, AB2, HOOK2) do { \
            PG8_LDB(B0, 0, 0); PG8_LDB(B1, 0, 1); PG8_SCHED; PG8_LDA(At, 0, 0); PG8_STAGE_A(PG8_SA(1, 1), KK1, aoC, baseC, 1); \
            PG8_WAIT_V(8); PG8_WAIT_L(0); PG8_BAR; PG8_MMA(0, 0, At, B0); PG8_MMA(0, 1, At, B1); PG8_BAR; PG8_SCHED; \
            HOOK2; PG8_LDA(At, 0, 1); PG8_STAGE_B(PG8_SB(0, 0), PB2, 0); PG8_STAGE_B(PG8_SB(0, 1), PB2, 1); PG8_STAGE_A(PG8_SA(0, 0), KK2, AO2, AB2, 0); \
            PG8_WAIT_V(8); PG8_WAIT_L(0); PG8_BAR; PG8_MMA(1, 0, At, B0); PG8_MMA(1, 1, At, B1); PG8_BAR; PG8_SCHED; \
            PG8_LDB(B0, 1, 0); PG8_LDB(B1, 1, 1); PG8_SCHED; PG8_LDA(At, 1, 0); PG8_STAGE_A(PG8_SA(0, 1), KK2, AO2, AB2, 1); \
            PG8_WAIT_V(8); PG8_WAIT_L(0); PG8_BAR; PG8_MMA(0, 0, At, B0); PG8_MMA(0, 1, At, B1); PG8_BAR; PG8_SCHED; \
            PG8_LDA(At, 1, 1); PG8_STAGE_B(PG8_SB(1, 0), PB3, 0); PG8_STAGE_B(PG8_SB(1, 1), PB3, 1); PG8_STAGE_A(PG8_SA(1, 0), KK3, AO2, AB2, 0); \
            PG8_WAIT_V(8); PG8_WAIT_L(0); PG8_BAR; PG8_MMA(1, 0, At, B0); PG8_MMA(1, 1, At, B1); PG8_BAR; PG8_SCHED; } while (0)
    typename Sched::Unit cur, nxt; int ui = 0;
    if (!S.next(0, cur)) return;
    f32x4 acc[2][2][4][2];
#pragma unroll
    for (int a = 0; a < 2; ++a)
#pragma unroll
        for (int b = 0; b < 2; ++b)
#pragma unroll
            for (int m = 0; m < 4; ++m)
#pragma unroll
                for (int n = 0; n < 2; ++n) acc[a][b][m][n] = (f32x4){0.f, 0.f, 0.f, 0.f};
    typedef typename FragT<Epi::FP8>::T frag_t;
    frag_t At[4], B0[2], B1[2];
    unsigned aoC[2][2] = {{0u, 0u}, {0u, 0u}}, voffA[2] = {0u, 0u};
    unsigned baseC = 0, baseN = 0;
    if constexpr (LANEC) { S.a_lane(tid, voffA); baseC = S.a_base(cur); } else S.a_offs(cur, tid, aoC);
    const char* cB = gB + S.b_off(cur);
    PG8_STAGE_B(PG8_SB(0, 0), cB, 0); PG8_STAGE_B(PG8_SB(0, 1), cB, 1); PG8_STAGE_A(PG8_SA(0, 0), 0, aoC, baseC, 0); PG8_STAGE_A(PG8_SA(0, 1), 0, aoC, baseC, 1);
    if (wr == 1) PG8_BAR;
    PG8_WAIT_V(2); PG8_BAR;
    PG8_STAGE_B(PG8_SB(1, 0), cB + kstep, 0); PG8_STAGE_A(PG8_SA(1, 0), kstep, aoC, baseC, 0); PG8_STAGE_B(PG8_SB(1, 1), cB + kstep, 1);
    PG8_WAIT_V(6); PG8_BAR;
    for (;;) {
        const bool has_next = S.next(ui + 1, nxt);
        const char* nB = cB;
        unsigned aoN[2][2];
#pragma unroll
        for (int h = 0; h < 2; ++h)
#pragma unroll
            for (int i = 0; i < 2; ++i) aoN[h][i] = aoC[h][i];
        baseN = baseC;
        if (has_next) { nB = gB + S.b_off(nxt); if constexpr (LANEC) baseN = S.a_base(nxt); else S.a_offs(nxt, LEAN ? TIDX : tid, aoN); }
        if constexpr (STASH) *((LAS u32x4*)(lds + STASH_OFF) + TIDX) = (u32x4){aoN[0][0], aoN[0][1], aoN[1][0], aoN[1][1]};
#pragma unroll 1
        for (int t = 0; t < nt; t += 2) {
            const bool last = (t == nt - 2);
            const size_t k1 = (size_t)(t + 1) * kstep;
            const size_t k2 = last ? (size_t)0 : (size_t)(t + 2) * kstep, k3 = k2 + kstep;
            const char* b2 = last ? nB : cB + (size_t)(t + 2) * kstep; const char* b3 = b2 + kstep;
            const unsigned base2 = last ? baseN : baseC;
            unsigned ao2[2][2];
            if constexpr (STASH) {
                const u32x4 sv = *((const LAS u32x4*)(lds + STASH_OFF) + TIDX);
                PG8_STEP(k1, k2, k3, b2, b3, ao2, base2, (ao2[0][0] = last ? sv.x : aoC[0][0], ao2[0][1] = last ? sv.y : aoC[0][1], ao2[1][0] = last ? sv.z : aoC[1][0], ao2[1][1] = last ? sv.w : aoC[1][1]));
            } else {
#pragma unroll
                for (int h = 0; h < 2; ++h)
#pragma unroll
                    for (int i = 0; i < 2; ++i) ao2[h][i] = last ? aoN[h][i] : aoC[h][i];
                PG8_STEP(k1, k2, k3, b2, b3, ao2, base2, (void)0);
            }
        }
        if constexpr (STASH) { const u32x4 sv = *((const LAS u32x4*)(lds + STASH_OFF) + TIDX); aoC[0][0] = sv.x; aoC[0][1] = sv.y; aoC[1][0] = sv.z; aoC[1][1] = sv.w; }
        else {
#pragma unroll
            for (int h = 0; h < 2; ++h)
#pragma unroll
                for (int i = 0; i < 2; ++i) aoC[h][i] = aoN[h][i];
        }
        if constexpr (ALIGN_EPI) { if (wr == 0) PG8_BAR; }
        if constexpr (LEAN) { const int le = lane_now(); E(acc, cur, wr, wc, le & 15, le >> 4); }
        else E(acc, cur, wr, wc, fr, fq);
        if (!has_next) break;
#pragma unroll
        for (int a = 0; a < 2; ++a)
#pragma unroll
            for (int b = 0; b < 2; ++b)
#pragma unroll
                for (int m = 0; m < 4; ++m)
#pragma unroll
                    for (int n = 0; n < 2; ++n) acc[a][b][m][n] = (f32x4){0.f, 0.f, 0.f, 0.f};
        cur = nxt; cB = nB; baseC = baseN; ++ui;
        if constexpr (ALIGN_EPI) { if (wr == 1) PG8_BAR; }
    }
    PG8_WAIT_V(0);
    if constexpr (!ALIGN_EPI) { if (wr == 0) PG8_BAR; }
    PG8_BAR;
#undef PG8_SA
#undef PG8_SB
#undef PG8_STAGE_A
#undef PG8_STAGE_B
#undef PG8_LDA
#undef PG8_LDB
#undef PG8_MMA
#undef PG8_WAIT_V
#undef PG8_WAIT_L
#undef PG8_BAR
#undef PG8_SCHED
#undef PG8_STEP
}
}

struct EpiQKV {
    static constexpr int PERM = 1; static constexpr bool FP8 = true;
    bf16* U; const float* rope; int nostore;
    __device__ __forceinline__ void operator()(const f32x4 (&acc)[2][2][4][2], const pg8::DUnit& u, int wr, int wc, int fr, int fq) const {
        const int grp = u.pn >> 2;
        const int row0 = u.pm * 256 + wr * 64 + fr, col0 = u.pn * 256 + wc * 32 + 8 * fq;
        const float sc = ((grp == 0) ? (RSQ_HD * LOG2E) : ((grp == 4) ? RSQ_HD : 1.0f)) * (1.0f / WSCALE);
        const bool rot = (grp == 3) || (grp == 4);
        f32x4 cc[2][4][2];
#pragma unroll
        for (int ai = 0; ai < 2; ++ai)
#pragma unroll
            for (int m = 0; m < 4; ++m) { const int row = row0 + ai * 128 + m * 16; cc[ai][m][0] = (f32x4){1.f, 0.f, 1.f, 0.f}; cc[ai][m][1] = cc[ai][m][0];
                if (rot) { const float* rp = rope + ((size_t)(row & (SEQ - 1)) * 64 + 16 * wc + 4 * fq) * 2; cc[ai][m][0] = *(const GAS f32x4*)rp; cc[ai][m][1] = *(const GAS f32x4*)(rp + 4); } }
#pragma unroll
        for (int ai = 0; ai < 2; ++ai)
#pragma unroll
            for (int m = 0; m < 4; ++m) { const int row = row0 + ai * 128 + m * 16; bf16* rowp = U + (size_t)row * INC + col0;
                const f32x4 c0 = cc[ai][m][0], c1 = cc[ai][m][1];
#pragma unroll
                for (int bj = 0; bj < 2; ++bj) { f32x4 v0 = acc[ai][bj][m][0], v1 = acc[ai][bj][m][1];
                    if (rot) {
                        const f32x4 a = v0, b = v1;
                        v0.x = a.x * c0.x - a.y * c0.y; v0.y = a.x * c0.y + a.y * c0.x; v0.z = a.z * c0.z - a.w * c0.w; v0.w = a.z * c0.w + a.w * c0.z;
                        v1.x = b.x * c1.x - b.y * c1.y; v1.y = b.x * c1.y + b.y * c1.x; v1.z = b.z * c1.z - b.w * c1.w; v1.w = b.z * c1.w + b.w * c1.z;
                    }
                    v0 = v0 * sc; v1 = v1 * sc;
                    u32x4 w; w.x = cvtpk(v0.x, v0.y); w.y = cvtpk(v0.z, v0.w); w.z = cvtpk(v1.x, v1.y); w.w = cvtpk(v1.z, v1.w);
                    if (!nostore) *(GAS u32x4*)(rowp + bj * 128) = w; else asm volatile("" :: "v"(w)); } }
    }
};
struct EpiResid {
    static constexpr int PERM = 0; static constexpr bool FP8 = true;
    const float* X; float* X1; const float* modv;
    __device__ __forceinline__ void operator()(const f32x4 (&acc)[2][2][4][2], const pg8::DUnit& u, int wr, int wc, int fr, int fq) const {
        const int row0 = u.pm * 256 + wr * 64 + fr, col0 = u.pn * 256 + wc * 32 + 4 * fq, b = u.pm >> 4;
        f32x4 gv[2][2];
#pragma unroll
        for (int bj = 0; bj < 2; ++bj)
#pragma unroll
            for (int n = 0; n < 2; ++n) gv[bj][n] = *(const GAS f32x4*)(modv + b * 16384 + 4096 + col0 + bj * 128 + n * 16) * (1.0f / WSCALE);
#pragma unroll
        for (int ai = 0; ai < 2; ++ai) {
            f32x4 xv[4][2][2];
#pragma unroll
            for (int m = 0; m < 4; ++m) { const size_t off = (size_t)(row0 + ai * 128 + m * 16) * D + col0;
#pragma unroll
                for (int bj = 0; bj < 2; ++bj)
#pragma unroll
                    for (int n = 0; n < 2; ++n) xv[m][bj][n] = *(const GAS f32x4*)(X + off + bj * 128 + n * 16); }
#pragma unroll
            for (int m = 0; m < 4; ++m) { const size_t off = (size_t)(row0 + ai * 128 + m * 16) * D + col0;
#pragma unroll
                for (int bj = 0; bj < 2; ++bj)
#pragma unroll
                    for (int n = 0; n < 2; ++n) *(GAS f32x4*)(X1 + off + bj * 128 + n * 16) = xv[m][bj][n] + gv[bj][n] * acc[ai][bj][m][n]; }
        }
    }
};

namespace mix {
constexpr int SHM = 16384;
#define KSWZ(row, colB) ((row) * 256 + ((colB) ^ (((row) & 7) << 4)))
__device__ __forceinline__ int v_st(int k, int c) { const int kk = (k & ~0xC) | ((k & 4) << 1) | ((k & 8) >> 1); return ((kk >> 3) * 4 + (c >> 5)) * 512 + ((kk & 7) * 32 + (c & 31)) * 2; }
__device__ __forceinline__ int v_rd_base(int lane) { return ((lane & 3) << 3) | (((lane >> 2) & 3) << 6) | (((lane >> 4) & 1) << 5) | (((lane >> 5) & 1) << 8); }
__device__ __forceinline__ int crow(int r, int hi) { return (r & 3) + 8 * (r >> 2) + 4 * hi; }
__device__ __forceinline__ int pinv(int k) { return ((k & 8) << 1) | ((k & 4) << 1) | ((k & 16) >> 2) | (k & 3); }
#define TRRD(dst, base, off) dst = __builtin_amdgcn_ds_read_tr16_b64_v4i16((LAS s16x4*)((LAS unsigned char*)(uintptr_t)(unsigned)(base) + (off)))
#define PK4(P, B_, OUT) do { unsigned a0 = cvtpk(P[B_+0], P[B_+1]), a1 = cvtpk(P[B_+2], P[B_+3]);                          \
        unsigned b0 = cvtpk(P[B_+4], P[B_+5]), b1 = cvtpk(P[B_+6], P[B_+7]);                                             \
        auto r0 = __builtin_amdgcn_permlane32_swap(a0, b0, false, false); auto r1 = __builtin_amdgcn_permlane32_swap(a1, b1, false, false); \
        u32x4 w = {r0[0], r1[0], r0[1], r1[1]}; OUT = *reinterpret_cast<bf16x8*>(&w); } while (0)
__device__ __forceinline__ bf16x8 cat8(s16x4 l, s16x4 h) { return (bf16x8){l[0], l[1], l[2], l[3], h[0], h[1], h[2], h[3]}; }

template <int KB>
__device__ __forceinline__ void qkt(f32x16& p0, f32x16& p1, const char* K_lds, int r32, int hi, const bf16x8* qr) {
    p0 = f32x16{}; p1 = f32x16{};
    const char* kb[4];
#pragma unroll
    for (int dd = 0; dd < 4; ++dd) kb[dd] = K_lds + KB * SHM + KSWZ(r32, (dd * 16 + hi * 8) * 2);
#pragma unroll
    for (int d0 = 0; d0 < 8; ++d0) { const char* a = kb[d0 & 3] + (d0 >> 2) * 128;
        bf16x8 b0 = *reinterpret_cast<const bf16x8*>(a);
        bf16x8 b1 = *reinterpret_cast<const bf16x8*>(a + 32 * 256);
        p0 = __builtin_amdgcn_mfma_f32_32x32x16_bf16(b0, qr[d0], p0, 0, 0, 0);
        p1 = __builtin_amdgcn_mfma_f32_32x32x16_bf16(b1, qr[d0], p1, 0, 0, 0); }
}
template <int VB>
__device__ __forceinline__ void pv_tile(f32x16* o, int vb0, bf16x8 pa0, bf16x8 pa1, bf16x8 pa2, bf16x8 pa3) {
#define PV_D0(d0) do { s16x4 l0, l1, l2, l3, h0, h1, h2, h3; constexpr int b_ = VB * SHM + (d0) * 512; \
        TRRD(l0, vb0, b_); TRRD(h0, vb0, b_ + 2048); TRRD(l1, vb0, b_ + 4096); TRRD(h1, vb0, b_ + 6144); TRRD(l2, vb0, b_ + 8192); TRRD(h2, vb0, b_ + 10240); TRRD(l3, vb0, b_ + 12288); TRRD(h3, vb0, b_ + 14336); \
        \
        o[d0] = __builtin_amdgcn_mfma_f32_32x32x16_bf16(pa0, cat8(l0, h0), o[d0], 0, 0, 0);   \
        o[d0] = __builtin_amdgcn_mfma_f32_32x32x16_bf16(pa1, cat8(l1, h1), o[d0], 0, 0, 0);   \
        o[d0] = __builtin_amdgcn_mfma_f32_32x32x16_bf16(pa2, cat8(l2, h2), o[d0], 0, 0, 0);   \
        o[d0] = __builtin_amdgcn_mfma_f32_32x32x16_bf16(pa3, cat8(l3, h3), o[d0], 0, 0, 0); } while (0)
    PV_D0(0); PV_D0(1); PV_D0(2); PV_D0(3);
#undef PV_D0
}
__device__ __forceinline__ void sb_weights(f32x16& p0, f32x16& p1, float& Rrun, int hi) {
    float T1 = 1.f, T0 = 1.f;
#pragma unroll
    for (int r = 0; r < 16; ++r) { const float e = fast_exp2(fminf(p1[r], 80.f)); const float om = fast_rcp(1.0f + e); p1[r] = e * om; T1 *= om; }
#pragma unroll
    for (int r = 0; r < 16; ++r) { const float e = fast_exp2(fminf(p0[r], 80.f)); const float om = fast_rcp(1.0f + e); p0[r] = e * om; T0 *= om; }
    const auto s1 = __builtin_amdgcn_permlane32_swap(__float_as_uint(T1), __float_as_uint(T1), false, false);
    const auto s0 = __builtin_amdgcn_permlane32_swap(__float_as_uint(T0), __float_as_uint(T0), false, false);
    const float T1p = __uint_as_float(hi ? s1[0] : s1[1]), T0p = __uint_as_float(hi ? s0[0] : s0[1]);
    const float t11 = T1 * T1p;
    float run = hi ? Rrun : Rrun * T1p;
#pragma unroll
    for (int r = 15; r >= 0; --r) { const float w = p1[r] * run; run -= w; p1[r] = w; }
    run = Rrun * t11 * (hi ? 1.0f : T0p);
#pragma unroll
    for (int r = 15; r >= 0; --r) { const float w = p0[r] * run; run -= w; p0[r] = w; }
    Rrun = Rrun * t11 * (T0 * T0p);
}
__device__ __forceinline__ void store_o32(const f32x16* o, unsigned char* Ow, int ldo, int r32, int hi) {
    const unsigned lo = (unsigned)(4 * hi * ldo + r32);
#pragma unroll
    for (int r = 0; r < 16; ++r) { unsigned char* rowp = Ow + (size_t)((r & 3) + 8 * (r >> 2)) * ldo;
#pragma unroll
        for (int d0 = 0; d0 < 4; ++d0) { const float v = o[d0][r]; const float v1 = __shfl_xor(v, 1), v2 = __shfl_xor(v, 2), v3 = __shfl_xor(v, 3);
            if ((r32 & 3) == 0) *(GAS unsigned*)(rowp + lo + d0 * 32) = pk_fp8x4(v, v1, v2, v3); } }
}

__device__ __forceinline__ void sb_part1(f32x16& p0, float& T0) {
    float t = 1.f;
#pragma unroll
    for (int r = 0; r < 16; ++r) { const float e = fast_exp2(fminf(p0[r], 80.f)); const float om = fast_rcp(1.0f + e); p0[r] = e * om; t *= om; }
    T0 = t;
}
__device__ __forceinline__ void sb_part2(f32x16& p0, f32x16& p1, float T0, float& Rrun, int hi, bf16x8& pa0, bf16x8& pa1, bf16x8& pa2, bf16x8& pa3) {
    float T1 = 1.f;
#pragma unroll
    for (int r = 0; r < 16; ++r) { const float e = fast_exp2(fminf(p1[r], 80.f)); const float om = fast_rcp(1.0f + e); p1[r] = e * om; T1 *= om; }
    const auto s1 = __builtin_amdgcn_permlane32_swap(__float_as_uint(T1), __float_as_uint(T1), false, false);
    const auto s0 = __builtin_amdgcn_permlane32_swap(__float_as_uint(T0), __float_as_uint(T0), false, false);
    const float T1p = __uint_as_float(hi ? s1[0] : s1[1]), T0p = __uint_as_float(hi ? s0[0] : s0[1]);
    const float t11 = T1 * T1p;
    float run = hi ? Rrun : Rrun * T1p;
#pragma unroll
    for (int r = 15; r >= 0; --r) { const float w = p1[r] * run; run -= w; p1[r] = w; }
    run = Rrun * t11 * (hi ? 1.0f : T0p);
#pragma unroll
    for (int r = 15; r >= 0; --r) { const float w = p0[r] * run; run -= w; p0[r] = w; }
    Rrun = Rrun * t11 * (T0 * T0p);
    PK4(p0, 0, pa0); PK4(p0, 8, pa1); PK4(p1, 0, pa2); PK4(p1, 8, pa3);
}
__device__ __forceinline__ void qkt_rt(f32x16& p0, f32x16& p1, const LAS unsigned char* K_lds, int kbo, int r32, int hi, const bf16x8* qr) {
    p0 = f32x16{}; p1 = f32x16{};
    const LAS unsigned char* kb[4];
#pragma unroll
    for (int dd = 0; dd < 4; ++dd) kb[dd] = K_lds + kbo + KSWZ(r32, (dd * 16 + hi * 8) * 2);
#pragma unroll
    for (int d0 = 0; d0 < 8; ++d0) { const LAS unsigned char* a = kb[d0 & 3] + (d0 >> 2) * 128;
        bf16x8 b0 = *reinterpret_cast<const LAS bf16x8*>(a);
        bf16x8 b1 = *reinterpret_cast<const LAS bf16x8*>(a + 32 * 256);
        p0 = __builtin_amdgcn_mfma_f32_32x32x16_bf16(b0, qr[d0], p0, 0, 0, 0);
        p1 = __builtin_amdgcn_mfma_f32_32x32x16_bf16(b1, qr[d0], p1, 0, 0, 0); }
}
__device__ __forceinline__ void pv_rt(f32x16* o, int vb, bf16x8 pa0, bf16x8 pa1, bf16x8 pa2, bf16x8 pa3) {
#define PV_D0(d0) do { s16x4 l0, l1, l2, l3, h0, h1, h2, h3; constexpr int b_ = (d0) * 512; \
        TRRD(l0, vb, b_); TRRD(h0, vb, b_ + 2048); TRRD(l1, vb, b_ + 4096); TRRD(h1, vb, b_ + 6144); TRRD(l2, vb, b_ + 8192); TRRD(h2, vb, b_ + 10240); TRRD(l3, vb, b_ + 12288); TRRD(h3, vb, b_ + 14336); \
        \
        o[d0] = __builtin_amdgcn_mfma_f32_32x32x16_bf16(pa0, cat8(l0, h0), o[d0], 0, 0, 0);   \
        o[d0] = __builtin_amdgcn_mfma_f32_32x32x16_bf16(pa1, cat8(l1, h1), o[d0], 0, 0, 0);   \
        o[d0] = __builtin_amdgcn_mfma_f32_32x32x16_bf16(pa2, cat8(l2, h2), o[d0], 0, 0, 0);   \
        o[d0] = __builtin_amdgcn_mfma_f32_32x32x16_bf16(pa3, cat8(l3, h3), o[d0], 0, 0, 0); } while (0)
    PV_D0(0); PV_D0(1); SBAR(); PV_D0(2); PV_D0(3);
#undef PV_D0
}
__device__ __forceinline__ int key_of_row(int i) { const int j = i & 31; return (i & 32) + ((j >> 2) & 1) * 16 + ((j >> 3) & 3) * 4 + (j & 3); }
__device__ __forceinline__ void sb_all(f32x16& p0, f32x16& p1, float& Rrun, int hi, bf16x8& pa0, bf16x8& pa1, bf16x8& pa2, bf16x8& pa3) {
    float T1 = 1.f, T0 = 1.f;
#pragma unroll
    for (int r = 0; r < 16; ++r) { const float om = fast_rcp(1.0f + fast_exp2(p1[r])); p1[r] = 1.0f - om; T1 *= om; }
#pragma unroll
    for (int r = 0; r < 16; ++r) { const float om = fast_rcp(1.0f + fast_exp2(p0[r])); p0[r] = 1.0f - om; T0 *= om; }
    const auto s1 = __builtin_amdgcn_permlane32_swap(__float_as_uint(T1), __float_as_uint(T1), false, false);
    const auto s0 = __builtin_amdgcn_permlane32_swap(__float_as_uint(T0), __float_as_uint(T0), false, false);
    const float T1p = __uint_as_float(hi ? s1[0] : s1[1]), T0p = __uint_as_float(hi ? s0[0] : s0[1]);
    const float t11 = T1 * T1p;
    float run = hi ? Rrun : Rrun * T1p;
#pragma unroll
    for (int r = 15; r >= 0; --r) { const float w = p1[r] * run; run -= w; p1[r] = w; }
    run = Rrun * t11 * (hi ? 1.0f : T0p);
#pragma unroll
    for (int r = 15; r >= 0; --r) { const float w = p0[r] * run; run -= w; p0[r] = w; }
    Rrun = Rrun * t11 * (T0 * T0p);
    PK4(p0, 0, pa0); PK4(p0, 8, pa1); PK4(p1, 0, pa2); PK4(p1, 8, pa3);
}
__device__ __forceinline__ void attn_item(const bf16* U, bf16* O, int bh, int qb, LAS unsigned char* ldsl, char* lds, const int g_wv, const int pmode) {
    const int tid = TIDX, wid = g_wv, lane = tid & 63, r32 = lane & 31, hi = lane >> 5;
    const int b = bh >> 3, h = bh & 7;
    const bf16* Qp = U + (size_t)(b * SEQ + qb * 256) * INC + h * HD;
    const bf16* Kp = U + (size_t)(b * SEQ) * INC + 1024 + h * HD;
    const bf16* Vp = U + (size_t)(b * SEQ) * INC + 2048 + h * HD;
    const LAS unsigned char* K_lds = ldsl; char* V_lds = lds + 4 * SHM;
    bf16x8 qr[8];
    { const unsigned lo_q = (unsigned)((wid * 32 + r32) * INC + hi * 8);
#pragma unroll
      for (int d0 = 0; d0 < 8; ++d0) qr[d0] = *(const GAS bf16x8*)(Qp + lo_q + d0 * 16); }
    unsigned ksrc[2], vsrc[2];
#pragma unroll
    for (int i = 0; i < 2; ++i) { const int p = 2 * wid + i;
        { const int row = 4 * p + (lane >> 4), ch = (lane & 15) ^ (row & 7); ksrc[i] = (unsigned)(key_of_row(row) * INC + ch * 8); }
        { const int S = 2 * p + (lane >> 5), kk = (S >> 2) * 8 + ((lane & 31) >> 2), c = (S & 3) * 32 + (lane & 3) * 8; const int k = (kk & ~0xC) | ((kk & 4) << 1) | ((kk & 8) >> 1);
          vsrc[i] = (unsigned)(key_of_row(k) * INC + c); } }
    const int vb0 = (int)(uintptr_t)V_lds + v_rd_base(lane);
    const LAS unsigned char* kbase[4];
#pragma unroll
    for (int dd = 0; dd < 4; ++dd) kbase[dd] = K_lds + KSWZ(r32, (dd * 16 + hi * 8) * 2);
    const int NT = 4 * (qb + 1);
    const int qlo = qb * 256 + wid * 32;
    volatile LAS unsigned* eflag = (volatile LAS unsigned*)(ldsl + LDSCTL_OFF) + 32;
    const float RTH = 8.27e-25f;
#define DMA_TILE(t_) do { const size_t ro_ = (size_t)((pmode == 1 ? 0 : (NT - 1 - (t_))) * 64) * INC; const int so_ = ((t_) & 3) * SHM + wid * 2048; \
        _Pragma("unroll") for (int i_ = 0; i_ < 2; ++i_) { \
            __builtin_amdgcn_global_load_lds((const unsigned*)(Kp + ro_ + ksrc[i_]), (LAS unsigned*)(ldsl + so_ + i_ * 1024), 16, 0, 0); \
            __builtin_amdgcn_global_load_lds((const unsigned*)(Vp + ro_ + vsrc[i_]), (LAS unsigned*)(ldsl + 4 * SHM + so_ + i_ * 1024), 16, 0, 0); } } while (0)
#define SBMASK(P0_, P1_, t_) do { const int kb_ = (NT - 1 - (t_)) * 64; if (kb_ + 63 >= qlo) { const int dq = qlo + r32 - kb_ - 16 * hi; const float NEG = -__builtin_inff(); \
        _Pragma("unroll") for (int r = 0; r < 16; ++r) { if (r >= dq) P0_[r] = NEG; if (r + 32 >= dq) P1_[r] = NEG; } } } while (0)
#define WAITV(n_) asm volatile("s_waitcnt vmcnt(" #n_ ")" ::: "memory")
#define RBAR() do { asm volatile("s_waitcnt lgkmcnt(0)" ::: "memory"); __builtin_amdgcn_s_barrier(); asm volatile("" ::: "memory"); } while (0)
#define QK2(PX0, PX1, ko_, s_) do { const LAS unsigned char* a_ = kbase[(s_) & 3] + (ko_) + ((s_) >> 2) * 128; \
        const bf16x8 b0_ = *reinterpret_cast<const LAS bf16x8*>(a_), b1_ = *reinterpret_cast<const LAS bf16x8*>(a_ + 32 * 256); \
        PX0 = __builtin_amdgcn_mfma_f32_32x32x16_bf16(b0_, qr[s_], PX0, 0, 0, 0); PX1 = __builtin_amdgcn_mfma_f32_32x32x16_bf16(b1_, qr[s_], PX1, 0, 0, 0); } while (0)
#define EB(P_, r_, T_) do { const float om_ = fast_rcp(1.0f + fast_exp2(P_[r_])); P_[r_] = 1.0f - om_; T_ *= om_; } while (0)
#define WB(P_, r_) do { float w_; asm("v_mul_f32 %0, %1, %2" : "=v"(w_) : "v"(P_[r_]), "v"(run)); asm("v_sub_f32 %0, %1, %2" : "=v"(run) : "v"(run), "v"(w_)); P_[r_] = w_; } while (0)
#define BLOCK1(PX0, PX1, PY0, PY1, T0Y, ko_) do { PX0 = f32x16{}; PX1 = f32x16{}; float T1 = 1.f, run, T1p, T0p, t11; \
        QK2(PX0, PX1, ko_, 0); EB(PY1, 0, T1); EB(PY1, 1, T1); EB(PY1, 2, T1); EB(PY1, 3, T1); EB(PY1, 4, T1); EB(PY1, 5, T1); SBAR(); \
        QK2(PX0, PX1, ko_, 1); EB(PY1, 6, T1); EB(PY1, 7, T1); EB(PY1, 8, T1); EB(PY1, 9, T1); EB(PY1, 10, T1); SBAR(); \
        QK2(PX0, PX1, ko_, 2); EB(PY1, 11, T1); EB(PY1, 12, T1); EB(PY1, 13, T1); EB(PY1, 14, T1); EB(PY1, 15, T1); \
        { const auto s1_ = __builtin_amdgcn_permlane32_swap(__float_as_uint(T1), __float_as_uint(T1), false, false); const auto s0_ = __builtin_amdgcn_permlane32_swap(__float_as_uint(T0Y), __float_as_uint(T0Y), false, false); \
          T1p = __uint_as_float(hi ? s1_[0] : s1_[1]); T0p = __uint_as_float(hi ? s0_[0] : s0_[1]); t11 = T1 * T1p; run = hi ? Rrun : Rrun * T1p; } SBAR(); \
        QK2(PX0, PX1, ko_, 3); WB(PY1, 15); WB(PY1, 14); WB(PY1, 13); WB(PY1, 12); WB(PY1, 11); WB(PY1, 10); WB(PY1, 9); WB(PY1, 8); SBAR(); \
        QK2(PX0, PX1, ko_, 4); WB(PY1, 7); WB(PY1, 6); WB(PY1, 5); WB(PY1, 4); WB(PY1, 3); WB(PY1, 2); WB(PY1, 1); WB(PY1, 0); run = Rrun * t11 * (hi ? 1.0f : T0p); SBAR(); \
        QK2(PX0, PX1, ko_, 5); WB(PY0, 15); WB(PY0, 14); WB(PY0, 13); WB(PY0, 12); WB(PY0, 11); WB(PY0, 10); WB(PY0, 9); WB(PY0, 8); SBAR(); \
        QK2(PX0, PX1, ko_, 6); WB(PY0, 7); WB(PY0, 6); WB(PY0, 5); WB(PY0, 4); WB(PY0, 3); WB(PY0, 2); WB(PY0, 1); WB(PY0, 0); Rrun = Rrun * t11 * (T0Y * T0p); SBAR(); \
        QK2(PX0, PX1, ko_, 7); PK4(PY0, 0, pa0); PK4(PY0, 8, pa1); PK4(PY1, 0, pa2); PK4(PY1, 8, pa3); SBAR(); } while (0)
#define PART1(P0_, T0_) do { float t_ = 1.f; _Pragma("unroll") for (int r = 0; r < 16; ++r) EB(P0_, r, t_); T0_ = t_; } while (0)
    DMA_TILE(0); DMA_TILE(1);
    WAITV(4); RBAR();
    float Rrun = 1.f, T0A, T0B; f32x16 o[4] = {};
    f32x16 pA0, pA1, pB0, pB1; bf16x8 pa0, pa1, pa2, pa3;
    DMA_TILE(2);
    qkt_rt(pA0, pA1, K_lds, 0, r32, hi, qr);
    SBMASK(pA0, pA1, 0); PART1(pA0, T0A);
    WAITV(4); RBAR();
#define STEP(PX0, PX1, T0X, PY0, PY1, T0Y, t_) do { \
        if ((t_) + 2 < NT) DMA_TILE((t_) + 2); SBAR(); \
        BLOCK1(PX0, PX1, PY0, PY1, T0Y, ((t_) & 3) * SHM); \
        { const bool wd_ = __all(Rrun < RTH); if (lane == 0) eflag[((t_) & 1) * 8 + wid] = wd_ ? 1u : 0u; } \
        pv_rt(o, vb0 + (((t_) - 1) & 3) * SHM, pa0, pa1, pa2, pa3); \
        SBMASK(PX0, PX1, t_); PART1(PX0, T0X); SBAR(); \
        if ((t_) + 2 < NT) WAITV(4); else WAITV(0); \
        RBAR(); \
        { unsigned s_ = 0u; _Pragma("unroll") for (int w_ = 0; w_ < 8; ++w_) s_ += eflag[((t_) & 1) * 8 + w_]; done = ((unsigned)__builtin_amdgcn_readfirstlane((int)s_) == 8u) && (pmode == 0); } } while (0)
    int t = 1, NTe = NT; bool done = false;
    for (; t + 1 < NTe; t += 2) { STEP(pB0, pB1, T0B, pA0, pA1, T0A, t); STEP(pA0, pA1, T0A, pB0, pB1, T0B, t + 1); NTe = done ? 0 : NTe; }
    STEP(pB0, pB1, T0B, pA0, pA1, T0A, t);
    sb_part2(pB0, pB1, T0B, Rrun, hi, pa0, pa1, pa2, pa3); SBAR();
    pv_rt(o, vb0 + (t & 3) * SHM, pa0, pa1, pa2, pa3);
    asm volatile("s_waitcnt vmcnt(0)" ::: "memory");
#undef STEP
#undef BLOCK1
#undef PART1
#undef QK2
#undef EB
#undef WB
#undef DMA_TILE
#undef SBMASK
#undef WAITV
#undef RBAR
    store_o32(o, (unsigned char*)O + (size_t)(b * SEQ + qb * 256 + wid * 32) * D + h * HD, D, r32, hi);
}

__device__ __forceinline__ void ret_state_stream(const bf16* U, bf16* RTg, int bh, char* lds, const int g_wv) {
    const int tid = TIDX, wid = g_wv, lane = tid & 63, r32 = lane & 31, hi = lane >> 5;
    const int dkb = wid & 3, dvh = wid >> 2;
    const int b = bh >> 3, h = bh & 7;
    const float lg = __log2f(1.0f - __builtin_ldexpf(1.0f, -5 - h));
    const bf16* Kp = U + (size_t)(b * SEQ) * INC + 4096 + h * HD;
    const bf16* Vp = U + (size_t)(b * SEQ) * INC + 5120 + h * HD;
    const int sr = tid >> 4, sc = (tid & 15) * 8;
    const unsigned lo_kv = (unsigned)(sr * INC + sc);
    const int ktb0 = (int)(uintptr_t)lds + v_rd_base(lane) + dkb * 512, vtb0 = (int)(uintptr_t)(lds + 32768) + v_rd_base(lane) + dvh * 1024;
    const int ktb1 = ktb0 + 65536, vtb1 = vtb0 + 65536;
    bf16x8 ka[4], va[4], kb[4], vb[4];
    const float cd = fast_exp2(128.0f * lg);
    f32x16 Racc[2] = {};
#define SLOADS(n_, K_, V_) do { _Pragma("unroll") for (int i = 0; i < 4; ++i) { const size_t ro = (size_t)((n_) * 128 + 32 * i) * INC; K_[i] = *(const GAS bf16x8*)(Kp + ro + lo_kv); V_[i] = *(const GAS bf16x8*)(Vp + ro + lo_kv); } } while (0)
#define SWRITES(p_, K_, V_) do { float lgw = lg; asm volatile("" : "+v"(lgw)); _Pragma("unroll") for (int i = 0; i < 4; ++i) { const int c = sr + 32 * i, tile = i >> 1, cr = c & 63; \
        const float f = fast_exp2((float)(127 - c) * lgw); const u32x4 kw = *reinterpret_cast<const u32x4*>(&K_[i]); u32x4 kd; \
        kd.x = cvtpk(bflo(kw.x) * f, bfhi(kw.x) * f); kd.y = cvtpk(bflo(kw.y) * f, bfhi(kw.y) * f); kd.z = cvtpk(bflo(kw.z) * f, bfhi(kw.z) * f); kd.w = cvtpk(bflo(kw.w) * f, bfhi(kw.w) * f); \
        *(u32x4*)(lds + (p_) * 65536 + tile * SHM + v_st(cr, sc)) = kd; \
        *(bf16x8*)(lds + (p_) * 65536 + 32768 + tile * SHM + v_st(cr, sc)) = V_[i]; } } while (0)
#define SCOMPUTE(KTB, VTB) do { _Pragma("unroll") for (int r = 0; r < 16; ++r) { Racc[0][r] *= cd; Racc[1][r] *= cd; } \
        _Pragma("unroll") for (int tl = 0; tl < 2; ++tl) _Pragma("unroll") for (int ks = 0; ks < 4; ++ks) { s16x4 al, ah, bl0, bh0, bl1, bh1; const int o_ = tl * SHM + ks * 4096; \
            TRRD(al, KTB, o_); TRRD(ah, KTB, o_ + 2048); TRRD(bl0, VTB, o_); TRRD(bh0, VTB, o_ + 2048); TRRD(bl1, VTB, o_ + 512); TRRD(bh1, VTB, o_ + 512 + 2048); \
            const bf16x8 af = cat8(al, ah); \
            Racc[0] = __builtin_amdgcn_mfma_f32_32x32x16_bf16(af, cat8(bl0, bh0), Racc[0], 0, 0, 0); \
            Racc[1] = __builtin_amdgcn_mfma_f32_32x32x16_bf16(af, cat8(bl1, bh1), Racc[1], 0, 0, 0); } } while (0)
#define SSTORE(n1_) do { bf16* rt = RTg + (size_t)(bh * 32 + (n1_)) * 16384; _Pragma("unroll") for (int t = 0; t < 2; ++t) _Pragma("unroll") for (int g = 0; g < 4; ++g) { \
        u32x2 w; w.x = cvtpk(Racc[t][4 * g], Racc[t][4 * g + 1]); w.y = cvtpk(Racc[t][4 * g + 2], Racc[t][4 * g + 3]); \
        *(GAS u32x2*)(rt + (size_t)((2 * dvh + t) * 32 + r32) * 128 + dkb * 32 + 8 * g + 4 * hi) = w; } } while (0)
    SLOADS(0, ka, va); SLOADS(1, kb, vb);
    for (int n = 0; n < 31; n += 2) {
        SWRITES(0, ka, va); SBAR();
        if (n + 2 < 31) SLOADS(n + 2, ka, va);
        __syncthreads();
        SCOMPUTE(ktb0, vtb0); SSTORE(n + 1);
        if (n + 1 < 31) {
            SWRITES(1, kb, vb); SBAR();
            if (n + 3 < 31) SLOADS(n + 3, kb, vb);
            __syncthreads();
            SCOMPUTE(ktb1, vtb1); SSTORE(n + 2);
        }
    }
    __syncthreads();
#undef SLOADS
#undef SWRITES
#undef SCOMPUTE
#undef SSTORE
}

__device__ __forceinline__ float row16_sum(float s) {
    s += __builtin_bit_cast(float, __builtin_amdgcn_update_dpp(0, __builtin_bit_cast(int, s), 0xB1, 0xf, 0xf, false));
    s += __builtin_bit_cast(float, __builtin_amdgcn_update_dpp(0, __builtin_bit_cast(int, s), 0x4E, 0xf, 0xf, false));
    s += __builtin_bit_cast(float, __builtin_amdgcn_update_dpp(0, __builtin_bit_cast(int, s), 0x124, 0xf, 0xf, false));
    s += __builtin_bit_cast(float, __builtin_amdgcn_update_dpp(0, __builtin_bit_cast(int, s), 0x128, 0xf, 0xf, false));
    return s;
}
__device__ __forceinline__ void ret_chunk_items(const bf16* U, const bf16* RTg, bf16* O, const float* gn_g, char* lds, const int g_wv) {
    const int tid = TIDX, wid = g_wv, lane = tid & 63, r32 = lane & 31, hi = lane >> 5;
    const int ib = wid & 3, dvh = wid >> 2;
    char* KS = lds; char* VT = lds + 32768; char* GT = lds + 65536; char* RT = lds + 98304; float* SSQ = (float*)(lds + 131072);
    const int sr = tid >> 4, sc = (tid & 15) * 8;
    const unsigned lo_kv = (unsigned)(sr * INC + sc), lo_q = (unsigned)((ib * 32 + r32) * INC + hi * 8), lo_r = (unsigned)(sr * 128 + sc);
    const int vtb = (int)(uintptr_t)VT + v_rd_base(lane) + dvh * 1024;
    const char* ksb[4];
#pragma unroll
    for (int dd = 0; dd < 4; ++dd) ksb[dd] = KS + KSWZ(r32, (dd * 16 + hi * 8) * 2);
    const char* rtb[4];
#pragma unroll
    for (int dd = 0; dd < 4; ++dd) rtb[dd] = RT + KSWZ(dvh * 64 + r32, (dd * 16 + hi * 8) * 2);
    bf16x8 sk[4], sv[4], sg[4], srr[4], qr[8];
    const int G = (int)gridDim.x;
#define RC_BASE(it_) const int bh_ = (it_) & 31, n_ = (it_) >> 5, b_ = bh_ >> 3, h_ = bh_ & 7; const size_t rowbase_ = (size_t)(b_ * SEQ + n_ * 128)
#define RC_LOAD_KVG(it_) do { RC_BASE(it_); const bf16* Kp = U + rowbase_ * INC + 4096 + h_ * HD; const bf16* Vp = U + rowbase_ * INC + 5120 + h_ * HD; \
        _Pragma("unroll") for (int i = 0; i < 4; ++i) { const size_t ro = (size_t)(32 * i) * INC; sk[i] = *(const GAS bf16x8*)(Kp + ro + lo_kv); sv[i] = *(const GAS bf16x8*)(Vp + ro + lo_kv); } } while (0)
#define RC_LOAD_QR(it_) do { RC_BASE(it_); const bf16* Qp = U + rowbase_ * INC + 3072 + h_ * HD; const bf16* Gp = U + rowbase_ * INC + 6144 + h_ * HD; \
        _Pragma("unroll") for (int i = 0; i < 4; ++i) sg[i] = *(const GAS bf16x8*)(Gp + (size_t)(32 * i) * INC + lo_kv); \
        _Pragma("unroll") for (int d0 = 0; d0 < 8; ++d0) qr[d0] = *(const GAS bf16x8*)(Qp + lo_q + d0 * 16); \
        if (n_ > 0) { const bf16* rt = RTg + (size_t)(bh_ * 32 + n_) * 16384; \
            _Pragma("unroll") for (int i = 0; i < 4; ++i) srr[i] = *(const GAS bf16x8*)(rt + (size_t)(32 * i) * 128 + lo_r); } } while (0)
    int it = (int)blockIdx.x;
    if (it >= 1024) return;
    RC_LOAD_KVG(it); RC_LOAD_QR(it);
    for (; it < 1024; it += G) {
        RC_BASE(it);
        const float lg = __log2f(1.0f - __builtin_ldexpf(1.0f, -5 - h_));
#pragma unroll
        for (int i = 0; i < 4; ++i) { const int c = sr + 32 * i, tile = i >> 1, cr = c & 63;
            const float fs = fast_exp2(-(float)c * lg); const u32x4 kw = *reinterpret_cast<const u32x4*>(&sk[i]); u32x4 ke;
            ke.x = cvtpk(bflo(kw.x) * fs, bfhi(kw.x) * fs); ke.y = cvtpk(bflo(kw.y) * fs, bfhi(kw.y) * fs); ke.z = cvtpk(bflo(kw.z) * fs, bfhi(kw.z) * fs); ke.w = cvtpk(bflo(kw.w) * fs, bfhi(kw.w) * fs);
            *(u32x4*)(KS + tile * SHM + KSWZ(cr, sc * 2)) = ke;
            *(bf16x8*)(VT + tile * SHM + v_st(cr, sc)) = sv[i];
            *(bf16x8*)(GT + c * 256 + sc * 2) = sg[i];
            if (n_ > 0) *(bf16x8*)(RT + KSWZ(c, sc * 2)) = srr[i]; }
        SBAR();
        if (it + G < 1024) RC_LOAD_KVG(it + G);
        const float lf = fast_exp2((float)(ib * 32 + r32) * lg);
        __syncthreads();
        f32x16 acc[2] = {};
        if (n_ > 0) {
#pragma unroll
            for (int t = 0; t < 2; ++t)
#pragma unroll
                for (int s = 0; s < 8; ++s) { const bf16x8 rfr = *(const bf16x8*)(rtb[s & 3] + t * 8192 + (s >> 2) * 128); acc[t] = __builtin_amdgcn_mfma_f32_32x32x16_bf16(qr[s], rfr, acc[t], 0, 0, 0); }
#pragma unroll
            for (int r = 0; r < 16; ++r) { const float f = fast_exp2((float)(ib * 32 + crow(r, hi) + 1) * lg); acc[0][r] *= f; acc[1][r] *= f; }
        }
#pragma unroll
        for (int jb = 0; jb < 4; ++jb) {
            if (jb <= ib) {
                f32x16 p = {};
#pragma unroll
                for (int d0 = 0; d0 < 8; ++d0) { const bf16x8 kf = *(const bf16x8*)(ksb[d0 & 3] + (jb >> 1) * SHM + (jb & 1) * 8192 + (d0 >> 2) * 128);
                    p = __builtin_amdgcn_mfma_f32_32x32x16_bf16(kf, qr[d0], p, 0, 0, 0); }
#pragma unroll
                for (int r = 0; r < 16; ++r) { const int diff = (ib - jb) * 32 + r32 - crow(r, hi); p[r] = diff >= 0 ? p[r] * lf : 0.f; }
                bf16x8 pa0, pa1; PK4(p, 0, pa0); PK4(p, 8, pa1); SBAR();
#pragma unroll
                for (int t = 0; t < 2; ++t) { s16x4 l0, h0, l1, h1; const int o_ = (jb >> 1) * SHM + t * 512 + (jb & 1) * 8192;
                    TRRD(l0, vtb, o_); TRRD(h0, vtb, o_ + 2048); TRRD(l1, vtb, o_ + 4096); TRRD(h1, vtb, o_ + 6144);
                    acc[t] = __builtin_amdgcn_mfma_f32_32x32x16_bf16(pa0, cat8(l0, h0), acc[t], 0, 0, 0);
                    acc[t] = __builtin_amdgcn_mfma_f32_32x32x16_bf16(pa1, cat8(l1, h1), acc[t], 0, 0, 0); }
            }
        }
        SBAR();
        if (it + G < 1024) RC_LOAD_QR(it + G);
        float* ssqw = SSQ + wid * 32 + 4 * hi; const float* ssqp = SSQ + (wid ^ 4) * 32 + 4 * hi;
#pragma unroll
        for (int r = 0; r < 16; ++r) { float s = row16_sum(acc[0][r] * acc[0][r] + acc[1][r] * acc[1][r]); s += __shfl_xor(s, 16);
            if (r32 == 0) ssqw[(r & 3) + 8 * (r >> 2)] = s; }
        __syncthreads();
        {
            const float gn0 = gn_g[h_ * HD + dvh * 64 + r32], gn1 = gn_g[h_ * HD + dvh * 64 + 32 + r32];
            const char* gtp = GT + (ib * 32 + 4 * hi) * 256 + (dvh * 64 + r32) * 2; char* otp = KS + (ib * 32 + 4 * hi) * 256 + (dvh * 64 + r32) * 2;
#pragma unroll
            for (int r = 0; r < 16; ++r) { const int cr = (r & 3) + 8 * (r >> 2);
                const float rstd = __builtin_amdgcn_rsqf((ssqw[cr] + ssqp[cr]) * (1.0f / HD) + EPS);
                const float g0 = bf2f(*(const unsigned short*)(gtp + cr * 256)), g1 = bf2f(*(const unsigned short*)(gtp + cr * 256 + 64));
                const float v0 = acc[0][r] * rstd * gn0 * silu_f(g0), v1 = acc[1][r] * rstd * gn1 * silu_f(g1);
                *(unsigned short*)(otp + cr * 256) = (unsigned short)(cvtpk(v0, 0.f) & 0xffffu); *(unsigned short*)(otp + cr * 256 + 64) = (unsigned short)(cvtpk(v1, 0.f) & 0xffffu); }
        }
        __syncthreads();
        {
            unsigned char* Ow = (unsigned char*)O + rowbase_ * D + 1024 + h_ * HD;
#pragma unroll
            for (int i = 0; i < 4; ++i) { const int c = sr + 32 * i; const u32x4 w = *(const u32x4*)(KS + c * 256 + sc * 2); u32x2 o8;
                o8.x = pk_fp8x4(bflo(w.x), bfhi(w.x), bflo(w.y), bfhi(w.y)); o8.y = pk_fp8x4(bflo(w.z), bfhi(w.z), bflo(w.w), bfhi(w.w));
                *(GAS u32x2*)(Ow + (size_t)c * D + sc) = o8; }
        }
        __syncthreads();
    }
#undef RC_BASE
#undef RC_LOAD_KVG
#undef RC_LOAD_QR
}

__device__ __forceinline__ void p3_mixer(const Args& a, LAS unsigned char* ldsl, char* lds, const int g_wv, const int qoff, const int do_ret, const int pmode) {
    const bf16* U = (const bf16*)(a.ws + WS_U); bf16* O = (bf16*)(a.ws + WS_H1);
    unsigned* qhead = (unsigned*)(a.ws + WS_CTL) + CW_QHEAD + qoff;
    LAS unsigned* slot = (LAS unsigned*)(ldsl + LDSCTL_OFF) + 16;
    if ((do_ret & 1) && (int)blockIdx.x < 32) ret_state_stream(U, (bf16*)(a.ws + WS_ACT), (int)blockIdx.x, lds, g_wv);
    if (do_ret & 2) return;
    const int grp = (int)(blockIdx.x & 7);
    for (;;) {
        __syncthreads();
        if (TIDX == 0) *slot = __hip_atomic_fetch_add(qhead + 64 * grp + 64, 1u, __ATOMIC_RELAXED, __HIP_MEMORY_SCOPE_AGENT);
        __syncthreads();
        const unsigned it = *slot;
        if (it >= 64u) break;
        attn_item(U, pmode ? (bf16*)(a.ws + WS_ACT + 64 * MiB) : O, grp + 8 * (int)(it & 3u), 15 - (int)(it >> 2), ldsl, lds, g_wv, pmode);
    }
    if (qoff == 0 && pmode == 0) {
        unsigned* cq = (unsigned*)(a.ws + WS_CTL) + CW_CVQ;
        for (;;) {
            __syncthreads();
            if (TIDX == 0) *slot = __hip_atomic_fetch_add(cq, 1u, __ATOMIC_RELAXED, __HIP_MEMORY_SCOPE_AGENT);
            __syncthreads();
            const int clo = CV_SPLIT + (int)(*slot) * 64;
            if (clo >= CV_NIT) break;
            cvt_run<true>(a.ws, ldsl, g_wv, clo, (clo + 64 < CV_NIT) ? clo + 64 : CV_NIT, 1);
        }
    }
}
__device__ __forceinline__ void p3_ret_chunks(const Args& a, char* lds, const int g_wv) {
    const bf16* U = (const bf16*)(a.ws + WS_U); bf16* O = (bf16*)(a.ws + WS_H1);
    ret_chunk_items(U, (const bf16*)(a.ws + WS_ACT), O, a.in[I_RGN], lds, g_wv);
}
}

__device__ __forceinline__ void p5_router(const Args& a, LAS unsigned char* lds, const int g_wv, const int cbank, const int pm) {
    const int tid = TIDX, lane = tid & 63, wave = g_wv, G = gridDim.x, bx = blockIdx.x;
    const float* X1 = a.out; const float* modv = (const float*)(a.ws + WS_MOD); unsigned char* H2 = a.ws + WS_U;
    const float* Wr = a.in[I_WR]; const float rbias = a.in[I_RB][lane];
    unsigned* counts = (unsigned*)(a.ws + WS_CTL) + CW_CNT + cbank;
    int* LTOK = (int*)(a.ws + WS_LTOK); float* LW = (float*)(a.ws + WS_LW); unsigned* META = (unsigned*)(a.ws + WS_META);
    LAS float* h2f = (LAS float*)lds;
    constexpr int H2S = D + 8;
    LAS unsigned* lcnt = (LAS unsigned*)(lds + 16 * H2S * 4);
    LAS unsigned* lbase = lcnt + 64;
    LAS unsigned* rrec = lcnt + 128;
    LAS float* rgw = (LAS float*)(rrec + 1024);
    if (tid < 64) lcnt[tid] = 0u;
    __syncthreads();
    int ltile = 0;
    const bf16* Wrh = (const bf16*)(a.ws + WS_WR); const bf16* Wrl = Wrh + NE * D;
    f32x4 A[8], B[8]; int curb = -1;
    f32x4 vn[2][8];
    const int t0 = (int)((long)bx * (T / 16) / G), t1 = (int)((long)(bx + 1) * (T / 16) / G);
    if (t0 < t1) {
#pragma unroll
        for (int rr = 0; rr < 2; ++rr) { const GAS f32x4* xr = (const GAS f32x4*)(X1 + (size_t)(t0 * 16 + 2 * wave + rr) * D) + lane;
#pragma unroll
            for (int j = 0; j < 8; ++j) vn[rr][j] = xr[64 * j]; } }
    for (int tile = t0; tile < t1; ++tile) {
        const int row0 = tile * 16, b = row0 >> 12;
        if (b != curb) { curb = b;
#pragma unroll
            for (int j = 0; j < 8; ++j) { const int d = 4 * lane + 256 * j; const f32x4 g = *(const GAS f32x4*)(a.in[I_N2G] + d), sc = *(const GAS f32x4*)(modv + b * 16384 + 8192 + d);
                A[j] = g * (1.0f + sc); B[j] = *(const GAS f32x4*)(modv + b * 16384 + 6144 + d); } }
#pragma unroll
        for (int rr = 0; rr < 2; ++rr) { const int lr = 2 * wave + rr, row = row0 + lr;
            f32x4 v[8]; float ss = 0.f;
#pragma unroll
            for (int j = 0; j < 8; ++j) { v[j] = vn[rr][j]; ss += (v[j].x * v[j].x + v[j].y * v[j].y) + (v[j].z * v[j].z + v[j].w * v[j].w); }
            const float rstd = __builtin_amdgcn_rsqf(wave_sum(ss) * (1.0f / D) + EPS);
            GAS unsigned* o8 = (GAS unsigned*)(H2 + (size_t)row * D) + lane;
#pragma unroll
            for (int j = 0; j < 8; ++j) { const f32x4 h = v[j] * rstd * A[j] + B[j]; o8[64 * j] = pk_fp8x4(h.x, h.y, h.z, h.w);
                *(LAS f32x4*)(h2f + lr * H2S + 4 * lane + 256 * j) = h; } }
        __syncthreads();
        f32x4 acc[4];
#pragma unroll
        for (int nt = 0; nt < 4; ++nt) acc[nt] = (f32x4){0.f, 0.f, 0.f, 0.f};
        if (pm != 1) {
            const int mrow = lane & 15, kq = lane >> 4;
            const LAS float* ap = h2f + mrow * H2S + 256 * wave + 8 * kq;
            const bf16* bph = Wrh + ((size_t)(wave * 8) * 256 + lane) * 8; const bf16* bpl = Wrl + ((size_t)(wave * 8) * 256 + lane) * 8;
#pragma unroll 2
            for (int ks = 0; ks < 8; ++ks) {
                bf16x8 bh[4], bl[4];
#pragma unroll
                for (int nt = 0; nt < 4; ++nt) { bh[nt] = *(const GAS bf16x8*)(bph + (size_t)(ks * 4 + nt) * 512); bl[nt] = *(const GAS bf16x8*)(bpl + (size_t)(ks * 4 + nt) * 512); }
                const f32x4 x0 = *(const LAS f32x4*)(ap + 32 * ks), x1 = *(const LAS f32x4*)(ap + 32 * ks + 4);
                u32x4 hw, lw;
                hw.x = cvtpk(x0.x, x0.y); hw.y = cvtpk(x0.z, x0.w); hw.z = cvtpk(x1.x, x1.y); hw.w = cvtpk(x1.z, x1.w);
                lw.x = cvtpk(x0.x - bflo(hw.x), x0.y - bfhi(hw.x)); lw.y = cvtpk(x0.z - bflo(hw.y), x0.w - bfhi(hw.y)); lw.z = cvtpk(x1.x - bflo(hw.z), x1.y - bfhi(hw.z)); lw.w = cvtpk(x1.z - bflo(hw.w), x1.w - bfhi(hw.w));
                const bf16x8 ah = *reinterpret_cast<const bf16x8*>(&hw), al = *reinterpret_cast<const bf16x8*>(&lw);
#pragma unroll
                for (int nt = 0; nt < 4; ++nt) {
                    acc[nt] = __builtin_amdgcn_mfma_f32_16x16x32_bf16(ah, bh[nt], acc[nt], 0, 0, 0);
                    acc[nt] = __builtin_amdgcn_mfma_f32_16x16x32_bf16(al, bh[nt], acc[nt], 0, 0, 0);
                    acc[nt] = __builtin_amdgcn_mfma_f32_16x16x32_bf16(ah, bl[nt], acc[nt], 0, 0, 0); }
            }
        }
        if (tile + 1 < t1) {
#pragma unroll
            for (int rr = 0; rr < 2; ++rr) { const GAS f32x4* xr = (const GAS f32x4*)(X1 + (size_t)((tile + 1) * 16 + 2 * wave + rr) * D) + lane;
#pragma unroll
                for (int j = 0; j < 8; ++j) vn[rr][j] = xr[64 * j]; } }
        __syncthreads();
        { const int col = lane & 15, rq = lane >> 4;
#pragma unroll
            for (int nt = 0; nt < 4; ++nt)
#pragma unroll
                for (int i = 0; i < 4; ++i) h2f[(wave * 16 + rq * 4 + i) * 64 + nt * 16 + col] = acc[nt][i]; }
        __syncthreads();
        if (pm == 0 || pm == 3) {
            bool sel2[2]; float gw2[2]; int jj2[2];
#pragma unroll
            for (int rr = 0; rr < 2; ++rr) { const int lr = 2 * wave + rr;
                float logit = 0.f;
#pragma unroll
                for (int w = 0; w < 8; ++w) logit += h2f[(w * 16 + lr) * 64 + lane];
                const float s = fast_rcp(1.0f + fast_exp2(-logit * LOG2E));
                const float ch = s + rbias;
                float m1 = ch; m1 = fmaxf(m1, __shfl_xor(m1, 1)); m1 = fmaxf(m1, __shfl_xor(m1, 2)); m1 = fmaxf(m1, __shfl_xor(m1, 4));
                const unsigned long long bal = __ballot(ch == m1);
                const int g = lane >> 3; const unsigned gb = (unsigned)(bal >> (8 * g)) & 0xffu; const int first = __builtin_ctz(gb | 0x100u);
                float m2 = ((lane & 7) == first) ? -__builtin_inff() : ch; m2 = fmaxf(m2, __shfl_xor(m2, 1)); m2 = fmaxf(m2, __shfl_xor(m2, 2)); m2 = fmaxf(m2, __shfl_xor(m2, 4));
                const float gs = m1 + m2;
                int grank = 0;
#pragma unroll
                for (int gg = 0; gg < 8; ++gg) { const float v = __uint_as_float(__builtin_amdgcn_readlane(__float_as_uint(gs), 8 * gg)); grank += ((v > gs) || (v == gs && gg < g)) ? 1 : 0; }
                const bool gok = grank < 4;
                const float val = gok ? ch : -__builtin_inff();
                int rank = 0;
#pragma unroll
                for (int e2 = 0; e2 < 64; ++e2) { const float v = __uint_as_float(__builtin_amdgcn_readlane(__float_as_uint(val), e2)); rank += ((v > val) || (v == val && e2 < lane)) ? 1 : 0; }
                const bool sel = gok && rank < TOPK;
                const float ssum = wave_sum(sel ? s : 0.f);
                gw2[rr] = s / ssum * 2.5f; sel2[rr] = sel;
                const unsigned long long selmask = __ballot(sel);
                jj2[rr] = __builtin_popcountll(selmask & ((1ull << lane) - 1ull)); }
#pragma unroll
            for (int rr = 0; rr < 2; ++rr) if (sel2[rr]) { const unsigned off = __hip_atomic_fetch_add((unsigned*)(lcnt + lane), 1u, __ATOMIC_RELAXED, __HIP_MEMORY_SCOPE_WORKGROUP);
                const int lrow = ltile * 16 + 2 * wave + rr; if (jj2[rr] < TOPK) { rrec[lrow * 8 + jj2[rr]] = ((unsigned)lane << 16) | off; rgw[lrow * 8 + jj2[rr]] = gw2[rr]; } }
        }
        __syncthreads();
        ++ltile;
    }
    if (pm == 0 || pm == 3) {
        if (tid < 64) lbase[tid] = __hip_atomic_fetch_add(counts + 16 * tid, lcnt[tid], __ATOMIC_RELAXED, __HIP_MEMORY_SCOPE_AGENT);
        __syncthreads();
        for (int i = tid; i < ltile * 128; i += NTHR) { const int lrow = i >> 3, j = i & 7; const unsigned rec = rrec[i]; const int e = (int)(rec >> 16), slot = (int)(lbase[e] + (rec & 0xffffu));
            const int grow = (t0 + (lrow >> 4)) * 16 + (lrow & 15);
            LTOK[e * T + slot] = grow; LW[e * T + slot] = rgw[i]; META[grow * TOPK + j] = ((unsigned)e << 16) | (unsigned)slot; }
    }
}

struct MUnit { int e, pos0, s0, nv, pn; };
constexpr int TL_OFF = 131072, SEGB_OFF = 131072 + 8192;
__device__ __forceinline__ int build_tiles(const unsigned* counts, LAS int* tl, LAS int* segb, int xg, const int g_wv, const bool want_tiles) {
    const int tid = TIDX, lane = tid & 63;
    LAS int* ntl = segb + 80;
    if (tid < 64) {
        const int cnt = (int)__hip_atomic_load(counts + 16 * lane, __ATOMIC_RELAXED, __HIP_MEMORY_SCOPE_AGENT);
        const int nt = (cnt + 255) >> 8;
        int inc = nt;
#pragma unroll
        for (int o = 1; o < 64; o <<= 1) { const int v = __shfl_up(inc, o); if (lane >= o) inc += v; }
        const int st = inc - nt;
        segb[lane] = st * 256;
        if (want_tiles) {
            int rank = 0;
#pragma unroll
            for (int e2 = 0; e2 < 64; ++e2) { const int v = __builtin_amdgcn_readlane(nt, e2); rank += ((v > nt) || (v == nt && e2 < lane)) ? 1 : 0; }
            ntl[rank] = nt;
            asm volatile("s_waitcnt lgkmcnt(0)" ::: "memory");
            const int k = rank >> 3, q = rank & 7, grp = (k & 1) ? 7 - q : q;
            int loc = 0, tot = 0;
#pragma unroll
            for (int j = 0; j < 8; ++j) { const int v = ntl[8 * j + ((j & 1) ? 7 - grp : grp)]; if (j < k) loc += v; }
            { const int g = lane & 7;
#pragma unroll
              for (int j = 0; j < 8; ++j) tot += ntl[8 * j + ((j & 1) ? 7 - g : g)]; }
            int totg[8], mn = 1 << 30;
#pragma unroll
            for (int g = 0; g < 8; ++g) { totg[g] = __builtin_amdgcn_readlane(tot, g); mn = totg[g] < mn ? totg[g] : mn; }
            int L = mn;
            for (int it = 0; it < 4096; ++it) { int s = 0;
#pragma unroll
                for (int g = 0; g < 8; ++g) s += (L - totg[g]) > 0 ? (L - totg[g]) : 0;
                if (s >= 64) break; ++L; }
            int ns[8], sum = 0;
#pragma unroll
            for (int g = 0; g < 8; ++g) { ns[g] = (L - totg[g]) > 0 ? (L - totg[g]) : 0; sum += ns[g]; }
            int excess = sum - 64;
#pragma unroll
            for (int g = 0; g < 8; ++g) { if (excess > 0 && ns[g] > 0) { --ns[g]; --excess; } }
            int shstart = 0, mytot = 0, myns = 0;
#pragma unroll
            for (int g = 0; g < 8; ++g) { if (g < xg) shstart += ns[g]; if (g == xg) { mytot = totg[g]; myns = ns[g]; } }
            if (grp == xg) for (int t = 0; t < nt; ++t) { const int nv = (cnt - 256 * t) < 256 ? (cnt - 256 * t) : 256; tl[2 * (loc + t)] = lane | (nv << 8) | (t << 18); tl[2 * (loc + t) + 1] = st * 256 + 256 * t; }
            if (lane < myns) { const int mt = shstart + lane; tl[2 * (mytot + lane)] = 64 | (256 << 8) | (mt << 18); tl[2 * (mytot + lane) + 1] = SH_POS0 + 256 * mt; }
            if (lane == 0) segb[64] = mytot + myns;
        }
    }
    __syncthreads();
    return want_tiles ? __builtin_amdgcn_readfirstlane(segb[64]) : 0;
}
template <bool GATHER, int NPNS  >
struct MoeOrder {
    typedef MUnit Unit;
    const LAS int* tl; int ntile, j, stride, K; const int* ltok;
    __device__ __forceinline__ bool next(int i, MUnit& u) const {
        const int idx = j + stride * i, tile = idx >> NPNS; if (tile >= ntile) return false;
        const int w0 = tl[2 * tile], w1 = tl[2 * tile + 1];
        u.e = w0 & 0xff; u.nv = (w0 >> 8) & 0x3ff; u.s0 = (w0 >> 18) << 8; u.pos0 = w1; u.pn = idx & ((1 << NPNS) - 1); return true;
    }
    __device__ __forceinline__ void a_offs(const MUnit& u, int tid, unsigned (&ao)[2][2]) const {
        int lt[2][2] = {{0, 0}, {0, 0}};
        if (GATHER) {
            const int* lte = ltok + (u.e < 64 ? u.e : 63) * T + u.s0; const int rmax = u.nv - 1;
#pragma unroll
            for (int i = 0; i < 2; ++i) { int R, C; pg8::stage_rc(tid * 16 + i * 8192, R, C);
#pragma unroll
                for (int h = 0; h < 2; ++h) { const int r = h * 128 + R; lt[h][i] = lte[r < rmax ? r : rmax]; } }
            asm volatile("" : "+v"(lt[0][0]), "+v"(lt[0][1]), "+v"(lt[1][0]), "+v"(lt[1][1]));
        }
#pragma unroll
        for (int i = 0; i < 2; ++i) { int R, C; pg8::stage_rc(tid * 16 + i * 8192, R, C);
#pragma unroll
            for (int h = 0; h < 2; ++h) { const int r = h * 128 + R;
                if (GATHER) { const int tok = (u.e != 64) ? ((r < u.nv) ? lt[h][i] : 0) : (u.s0 + r); ao[h][i] = (unsigned)((tok * K + C) * 2); }
                else ao[h][i] = (unsigned)(((u.pos0 + r) * K + C) * 2); } }
    }
    __device__ __forceinline__ size_t b_off(const MUnit& u) const { return (size_t)((GATHER ? u.e * 1024 : u.e * 2048) + u.pn * 256) * K * 2; }
    static constexpr bool LANE_CONST = !GATHER;
    __device__ __forceinline__ unsigned a_base(const MUnit& u) const { return (unsigned)u.pos0 * (unsigned)(K * 2); }
    __device__ __forceinline__ void a_lane(int tid, unsigned (&vo)[2]) const {
#pragma unroll
        for (int i = 0; i < 2; ++i) { int R, C; pg8::stage_rc(tid * 16 + i * 8192, R, C); vo[i] = (unsigned)((R * K + C) * 2); }
    }
};
struct EpiGateUp {
    static constexpr int PERM = 1; static constexpr bool FP8 = true;
    unsigned char* ACT; const float* lw;
    __device__ __forceinline__ void operator()(const f32x4 (&acc)[2][2][4][2], const MUnit& u, int wr, int wc, int fr, int fq) const {
        float gwv[2][4];
        { const float* lwe = lw + (size_t)(u.e < 64 ? u.e : 63) * T + u.s0; const int rmax = u.nv - 1;
#pragma unroll
          for (int ai = 0; ai < 2; ++ai)
#pragma unroll
            for (int m = 0; m < 4; ++m) { const int r = ai * 128 + wr * 64 + m * 16 + fr; gwv[ai][m] = lwe[r < rmax ? r : rmax]; } }
#pragma unroll
        for (int ai = 0; ai < 2; ++ai)
#pragma unroll
            for (int m = 0; m < 4; ++m) { const int r = ai * 128 + wr * 64 + m * 16 + fr;
                const float gw = ((u.e != 64) ? ((r < u.nv) ? gwv[ai][m] : 0.f) : 1.0f) * (ASCALE / WSCALE);
                const f32x4 g0 = acc[ai][0][m][0] * (1.0f / WSCALE), g1 = acc[ai][0][m][1] * (1.0f / WSCALE), u0 = acc[ai][1][m][0], u1 = acc[ai][1][m][1];
                u32x2 w;
#define ACT8(g_, u_) __builtin_amdgcn_fmed3f(silu_f(g_) * (u_) * gw, -448.0f, 448.0f)
                w.x = pk_fp8x4(ACT8(g0.x, u0.x), ACT8(g0.y, u0.y), ACT8(g0.z, u0.z), ACT8(g0.w, u0.w));
                w.y = pk_fp8x4(ACT8(g1.x, u1.x), ACT8(g1.y, u1.y), ACT8(g1.z, u1.z), ACT8(g1.w, u1.w));
#undef ACT8
                *(GAS u32x2*)(ACT + (size_t)(u.pos0 + r) * FE + u.pn * 128 + wc * 32 + 8 * fq) = w; }
    }
};
struct EpiDown {
    static constexpr int PERM = 3; static constexpr bool FP8 = true;
    unsigned char* OUT; float* X1; const float* modv; int skip_shared;
    __device__ __forceinline__ void operator()(const f32x4 (&acc)[2][2][4][2], const MUnit& u, int wr, int wc, int fr, int fq) const {
        const int col0 = u.pn * 256 + wc * 64 + 16 * fq;
        if (u.e == 64 && skip_shared) return;
        if (u.e != 64) {
#pragma unroll
            for (int ai = 0; ai < 2; ++ai)
#pragma unroll
                for (int m = 0; m < 4; ++m) { const int r = ai * 128 + wr * 64 + m * 16 + fr; unsigned char* rowp = OUT + (size_t)(u.pos0 + r) * D + col0;
                    constexpr float DS = 1.0f / (WSCALE * ASCALE);
                    const f32x4 a0 = acc[ai][0][m][0] * DS, a1 = acc[ai][0][m][1] * DS, b0 = acc[ai][1][m][0] * DS, b1 = acc[ai][1][m][1] * DS;
                    u32x4 w; w.x = pk_fp8x4(a0.x, a0.y, a0.z, a0.w); w.y = pk_fp8x4(a1.x, a1.y, a1.z, a1.w); w.z = pk_fp8x4(b0.x, b0.y, b0.z, b0.w); w.w = pk_fp8x4(b1.x, b1.y, b1.z, b1.w);
                    __builtin_nontemporal_store(w, (GAS u32x4*)rowp); }
        } else {
            const int b = u.s0 >> 12;
            f32x4 gv[2][2];
#pragma unroll
            for (int bj = 0; bj < 2; ++bj)
#pragma unroll
                for (int n = 0; n < 2; ++n) gv[bj][n] = *(const GAS f32x4*)(modv + b * 16384 + 10240 + col0 + bj * 8 + 4 * n) * (1.0f / (WSCALE * ASCALE));
#pragma unroll
            for (int ai = 0; ai < 2; ++ai) {
                f32x4 xv[4][2][2];
#pragma unroll
                for (int m = 0; m < 4; ++m) { const int r = ai * 128 + wr * 64 + m * 16 + fr; const float* rowp = X1 + (size_t)(u.s0 + r) * D + col0;
#pragma unroll
                    for (int bj = 0; bj < 2; ++bj)
#pragma unroll
                        for (int n = 0; n < 2; ++n) xv[m][bj][n] = *(const GAS f32x4*)(rowp + bj * 8 + 4 * n); }
#pragma unroll
                for (int m = 0; m < 4; ++m) { const int r = ai * 128 + wr * 64 + m * 16 + fr; float* rowp = X1 + (size_t)(u.s0 + r) * D + col0;
#pragma unroll
                    for (int bj = 0; bj < 2; ++bj)
#pragma unroll
                        for (int n = 0; n < 2; ++n) *(GAS f32x4*)(rowp + bj * 8 + 4 * n) = xv[m][bj][n] + gv[bj][n] * acc[ai][bj][m][n]; }
            }
        }
    }
};

__device__ __forceinline__ void p8_final(const Args& a, LAS unsigned char* lds, const int g_wv, float* Xo) {
    const int tid = TIDX, lane = tid & 63, wave = g_wv;
    const int gw = blockIdx.x * NWAVES + wave, NGW = gridDim.x * NWAVES;
    const float* modv = (const float*)(a.ws + WS_MOD); const unsigned char* OUT = (const unsigned char*)(a.ws + WS_OUT); const unsigned* META = (const unsigned*)(a.ws + WS_META);
    float* X = a.out;
    LAS int* tl = (LAS int*)(lds + TL_OFF); LAS int* segb = (LAS int*)(lds + SEGB_OFF);
    (void)build_tiles((const unsigned*)(a.ws + WS_CTL) + CW_CNT, tl, segb, (int)(blockIdx.x & 7), g_wv, false);
    f32x4 A[8], B[8], G2[8]; int curb = -1;
    for (int row = (int)((long)gw * T / NGW), rowe = (int)((long)(gw + 1) * T / NGW); row < rowe; ++row) {
        const int b = row >> 12;
        if (b != curb) { curb = b;
#pragma unroll
            for (int i = 0; i < 8; ++i) { const int d = 4 * lane + 256 * i; const f32x4 g = *(const GAS f32x4*)(a.in[I_NFG] + d), sc = *(const GAS f32x4*)(modv + b * 16384 + 14336 + d);
                A[i] = g * (1.0f + sc); B[i] = *(const GAS f32x4*)(modv + b * 16384 + 12288 + d); G2[i] = *(const GAS f32x4*)(modv + b * 16384 + 10240 + d); } }
        f32x4 y[8];
#pragma unroll
        for (int i = 0; i < 8; ++i) y[i] = (f32x4){0.f, 0.f, 0.f, 0.f};
        const u32x4 m0 = *(const GAS u32x4*)(META + (size_t)row * 8), m1 = *(const GAS u32x4*)(META + (size_t)row * 8 + 4);
        const unsigned mm[8] = {m0.x, m0.y, m0.z, m0.w, m1.x, m1.y, m1.z, m1.w};
#pragma unroll
        for (int k = 0; k < 8; ++k) { const int e = (int)(mm[k] >> 16) & 63, slot = (int)(mm[k] & 0xffffu); const unsigned char* orow = OUT + (size_t)(segb[e] + slot) * D + 4 * lane;
#pragma unroll
            for (int i = 0; i < 8; ++i) { const unsigned w = __builtin_nontemporal_load((const GAS unsigned*)(orow + 256 * i));
                const f32x2 lo = __builtin_amdgcn_cvt_pk_f32_fp8((int)w, false), hi = __builtin_amdgcn_cvt_pk_f32_fp8((int)w, true);
                y[i] += (f32x4){lo.x, lo.y, hi.x, hi.y}; } }
        float ss = 0.f; f32x4 v[8];
#pragma unroll
        for (int i = 0; i < 8; ++i) { const f32x4 xv = *(const GAS f32x4*)(X + (size_t)row * D + 4 * lane + 256 * i); v[i] = xv + G2[i] * y[i];
            ss += (v[i].x * v[i].x + v[i].y * v[i].y) + (v[i].z * v[i].z + v[i].w * v[i].w); }
        const float rstd = __builtin_amdgcn_rsqf(wave_sum(ss) * (1.0f / D) + EPS);
#pragma unroll
        for (int i = 0; i < 8; ++i) __builtin_nontemporal_store(v[i] * rstd * A[i] + B[i], (GAS f32x4*)(Xo + (size_t)row * D + 4 * lane + 256 * i));
    }
}

__global__ void __launch_bounds__(NTHR, 2) fwd_kernel(Args args) {
    extern __shared__ __attribute__((aligned(16))) unsigned char lds_raw[];
    LAS unsigned char* lds = (LAS unsigned char*)lds_raw;
    const int g_wv = __builtin_amdgcn_readfirstlane((int)threadIdx.x >> 6);
    { const int tid = TIDX; for (int u = tid; u < 256; u += NTHR) ((LAS unsigned*)(lds + LDSCTL_OFF))[u] = 0u; }
    __syncthreads();
    if (TIDX == 0) { LAS unsigned long long* pt = (LAS unsigned long long*)(lds + LDSCTL_OFF + 256);
        pt[0] = (unsigned long long)(uintptr_t)args.in[I_WIN]; pt[1] = (unsigned long long)(uintptr_t)args.in[I_WOUT]; pt[2] = (unsigned long long)(uintptr_t)args.in[I_WG]; pt[3] = (unsigned long long)(uintptr_t)args.in[I_WU];
        pt[4] = (unsigned long long)(uintptr_t)args.in[I_WDN]; pt[5] = (unsigned long long)(uintptr_t)args.in[I_SG]; pt[6] = (unsigned long long)(uintptr_t)args.in[I_SU]; pt[7] = (unsigned long long)(uintptr_t)args.in[I_SD]; }
    __syncthreads();
    unsigned* ctl = (unsigned*)(args.ws + WS_CTL);
    const int lo = args.ph_lo, hi = args.ph_hi;
    XcdBarrier bar; bar.bar = ctl + CW_BAR; bar.x = 0; bar.st = nullptr;
    if (hi - lo > 1) bar = xcd_barrier_post(ctl + CW_BAR, (volatile LAS unsigned*)(lds + LDSCTL_OFF) + 8, g_wv);
#define IN(k) (lo <= (k) && (k) < hi)
#define SEAM(k) do { if (IN(k) && IN((k) + 1)) xcd_barrier(bar, g_wv); } while (0)
    float* modv = (float*)(args.ws + WS_MOD);
#define DUP(k) (DUP_PHASE == (k))
    if (IN(0)) { p0_prologue(args, lds, g_wv); if (DUP(0)) { xcd_barrier(bar, g_wv); p0_prologue(args, lds, g_wv); } } SEAM(0);
    if (IN(1)) { norm_rows_bf16<true>(args.in[I_X], args.in[I_N1G], modv, 0, 2048, (bf16*)(args.ws + WS_H1), g_wv);
        if (DUP(1)) { xcd_barrier(bar, g_wv); norm_rows_bf16<true>(args.in[I_X], args.in[I_N1G], modv, 0, 2048, (bf16*)(args.ws + WS_H1), g_wv); } } SEAM(1);
    if (IN(2)) {
        const int nu = (1792 + (int)gridDim.x - 1) / (int)gridDim.x, s = (int)(blockIdx.x % (unsigned)(nu > 0 ? nu : 1));
        { pg8::DenseOrder S1; S1.init(T, INC, D / 2, (int)gridDim.x, (int)blockIdx.x); S1.cnt = s; EpiQKV E1{(bf16*)(args.ws + WS_U), (const float*)(args.ws + WS_ROPE), 0};
          pg8::gemm_phase<pg8::DenseOrder, EpiQKV, true, true>(lds, (const char*)(args.ws + WS_H1), (const char*)(args.ws + WS_WIN), D / 2, S1, E1, g_wv); }
        cvt_run<true>(args.ws, lds, g_wv, CV_EARLY, CV_SPLIT); __syncthreads();
        { pg8::DenseOrder S2; S2.init(T, INC, D / 2, (int)gridDim.x, (int)blockIdx.x); S2.i0 = s; EpiQKV E2{(bf16*)(args.ws + WS_U), (const float*)(args.ws + WS_ROPE), 0};
          pg8::gemm_phase<pg8::DenseOrder, EpiQKV, true, true>(lds, (const char*)(args.ws + WS_H1), (const char*)(args.ws + WS_WIN), D / 2, S2, E2, g_wv); }
        if (DUP(2)) { xcd_barrier(bar, g_wv); pg8::DenseOrder S; S.init(T, INC, D / 2, (int)gridDim.x, (int)blockIdx.x); EpiQKV E{(bf16*)(args.ws + WS_U), (const float*)(args.ws + WS_ROPE), 0};
            pg8::gemm_phase<pg8::DenseOrder, EpiQKV, true, true>(lds, (const char*)(args.ws + WS_H1), (const char*)(args.ws + WS_WIN), D / 2, S, E, g_wv); }
    } SEAM(2);
    if (IN(3)) { mix::p3_mixer(args, lds, (char*)lds_raw, g_wv, 0, 1, 0); if (DUP(3)) { xcd_barrier(bar, g_wv); mix::p3_mixer(args, lds, (char*)lds_raw, g_wv, 1024, 1, 0); } if (DUP(13)) { xcd_barrier(bar, g_wv); mix::p3_mixer(args, lds, (char*)lds_raw, g_wv, 1024, 0, 0); } if (DUP(16)) { xcd_barrier(bar, g_wv); mix::p3_mixer(args, lds, (char*)lds_raw, g_wv, 1024, 0, 1); } if (DUP(17)) { xcd_barrier(bar, g_wv); mix::p3_mixer(args, lds, (char*)lds_raw, g_wv, 1024, 0, 2); } if (DUP(18)) { xcd_barrier(bar, g_wv); mix::p3_mixer(args, lds, (char*)lds_raw, g_wv, 1024, 0, 3); } if (DUP(19)) { xcd_barrier(bar, g_wv); mix::p3_mixer(args, lds, (char*)lds_raw, g_wv, 1024, 0, 4); } if (DUP(20)) { xcd_barrier(bar, g_wv); mix::p3_mixer(args, lds, (char*)lds_raw, g_wv, 1024, 0, 5); } if (DUP(15)) { xcd_barrier(bar, g_wv); mix::p3_mixer(args, lds, (char*)lds_raw, g_wv, 1024, 3, 0); }
        xcd_barrier(bar, g_wv); mix::p3_ret_chunks(args, (char*)lds_raw, g_wv); if (DUP(14)) { xcd_barrier(bar, g_wv); mix::p3_ret_chunks(args, (char*)lds_raw, g_wv); } } SEAM(3);
    if (IN(4)) { pg8::DenseOrder S; S.init(T, D, D / 2, (int)gridDim.x, (int)blockIdx.x);
        EpiResid E{args.in[I_X], args.out, modv};
        pg8::gemm_phase<pg8::DenseOrder, EpiResid, true, true>(lds, (const char*)(args.ws + WS_H1), (const char*)(args.ws + WS_WOUT), D / 2, S, E, g_wv);
        if (DUP(4)) { xcd_barrier(bar, g_wv); pg8::gemm_phase<pg8::DenseOrder, EpiResid, true, true>(lds, (const char*)(args.ws + WS_H1), (const char*)(args.ws + WS_WOUT), D / 2, S, E, g_wv); } } SEAM(4);
    if (IN(5)) { if (DUP(5)) { p5_router(args, lds, g_wv, 2048, 3); xcd_barrier(bar, g_wv); } if (DUP(51)) { p5_router(args, lds, g_wv, 2048, 1); xcd_barrier(bar, g_wv); } if (DUP(52)) { p5_router(args, lds, g_wv, 2048, 2); xcd_barrier(bar, g_wv); } p5_router(args, lds, g_wv, 0, 0); } SEAM(5);
    if (IN(6)) { LAS int* tl = (LAS int*)(lds + TL_OFF); LAS int* segb = (LAS int*)(lds + SEGB_OFF);
        const int ntile = build_tiles(ctl + CW_CNT, tl, segb, (int)(blockIdx.x & 7), g_wv, true);
        MoeOrder<true, 2> S{tl, ntile, (int)(blockIdx.x >> 3), (int)(gridDim.x >> 3), D / 2, (const int*)(args.ws + WS_LTOK)};
        EpiGateUp E{args.ws + WS_ACT, (const float*)(args.ws + WS_LW)};
        pg8::gemm_phase<MoeOrder<true, 2>, EpiGateUp, true, true>(lds, (const char*)(args.ws + WS_U), (const char*)(args.ws + WS_WGU), D / 2, S, E, g_wv);
        if (DUP(6)) { xcd_barrier(bar, g_wv); pg8::gemm_phase<MoeOrder<true, 2>, EpiGateUp, true, true>(lds, (const char*)(args.ws + WS_U), (const char*)(args.ws + WS_WGU), D / 2, S, E, g_wv); }
        if (DUP(61)) { pg8::gemm_phase<MoeOrder<true, 2>, EpiGateUp, true, true, 1>(lds, (const char*)(args.ws + WS_U), (const char*)(args.ws + WS_WGU), D / 2, S, E, g_wv); xcd_barrier(bar, g_wv); pg8::gemm_phase<MoeOrder<true, 2>, EpiGateUp, true, true>(lds, (const char*)(args.ws + WS_U), (const char*)(args.ws + WS_WGU), D / 2, S, E, g_wv); }
        if (DUP(62)) { pg8::gemm_phase<MoeOrder<true, 2>, EpiGateUp, true, true, 2>(lds, (const char*)(args.ws + WS_U), (const char*)(args.ws + WS_WGU), D / 2, S, E, g_wv); xcd_barrier(bar, g_wv); pg8::gemm_phase<MoeOrder<true, 2>, EpiGateUp, true, true>(lds, (const char*)(args.ws + WS_U), (const char*)(args.ws + WS_WGU), D / 2, S, E, g_wv); } } SEAM(6);
    if (IN(7)) { LAS int* tl = (LAS int*)(lds + TL_OFF); LAS int* segb = (LAS int*)(lds + SEGB_OFF);
        const int ntile = build_tiles(ctl + CW_CNT, tl, segb, (int)(blockIdx.x & 7), g_wv, true);
        MoeOrder<false, 3> S{tl, ntile, (int)(blockIdx.x >> 3), (int)(gridDim.x >> 3), FE / 2, nullptr};
        if (DUP(7)) { EpiDown E0{(unsigned char*)(args.ws + WS_OUT), args.out, modv, 1};
            pg8::gemm_phase<MoeOrder<false, 3>, EpiDown, true, true>(lds, (const char*)(args.ws + WS_ACT), (const char*)(args.ws + WS_WD), FE / 2, S, E0, g_wv); xcd_barrier(bar, g_wv); }
        EpiDown E{(unsigned char*)(args.ws + WS_OUT), args.out, modv, 0};
        pg8::gemm_phase<MoeOrder<false, 3>, EpiDown, true, true>(lds, (const char*)(args.ws + WS_ACT), (const char*)(args.ws + WS_WD), FE / 2, S, E, g_wv); } SEAM(7);
    if (DUP(99)) { for (int q = 0; q < 10; ++q) xcd_barrier(bar, g_wv); }
    if (IN(8)) { if (DUP(8)) { p8_final(args, lds, g_wv, (float*)(args.ws + WS_ACT)); xcd_barrier(bar, g_wv); } p8_final(args, lds, g_wv, args.out); }
#undef IN
#undef SEAM
}

#ifndef MK_ONE_LAUNCH
#define MK_ONE_LAUNCH 1
#endif
extern "C" void kernel_launch(void* const* d_in, const int* in_sizes, int n_in, void* d_out, int out_size, void* d_ws, size_t ws_size, hipStream_t stream) {
    static int grid = 0;
    if (grid == 0) {
        if (n_in != 20 || out_size != T * D || ws_size < WS_END) { fprintf(stderr, "kernel_launch: unexpected shapes (n_in %d out %d ws %zu need %zu)\n", n_in, out_size, ws_size, (size_t)WS_END); grid = -1; return; }
        int dev = 0, cus = 0, per_cu = 0;
        if (hipGetDevice(&dev) != hipSuccess || hipDeviceGetAttribute(&cus, hipDeviceAttributeMultiprocessorCount, dev) != hipSuccess) { grid = -1; return; }
        if (hipFuncSetAttribute((const void*)fwd_kernel, hipFuncAttributeMaxDynamicSharedMemorySize, LDS_BYTES) != hipSuccess) { fprintf(stderr, "kernel_launch: hipFuncSetAttribute failed\n"); grid = -1; return; }
        if (hipOccupancyMaxActiveBlocksPerMultiprocessor(&per_cu, (const void*)fwd_kernel, NTHR, LDS_BYTES) != hipSuccess || per_cu < 1) fprintf(stderr, "kernel_launch: occupancy query says %d\n", per_cu);
        (void)hipGetLastError();
        grid = cus & ~7;
        if (grid < 128) { fprintf(stderr, "kernel_launch: %d CUs: this kernel is built for a 256-CU MI355X (needs >= 128)\n", cus); grid = -1; return; }
    }
    if (grid < 0) return;
    (void)hipMemsetAsync((char*)d_ws + WS_CTL, 0, CTL_ZERO_BYTES, stream);
    Args a{};
    for (int i = 0; i < 20; ++i) a.in[i] = (const float*)d_in[i];
    a.out = (float*)d_out; a.ws = (unsigned char*)d_ws;
#if MK_ONE_LAUNCH
    a.ph_lo = 0; a.ph_hi = NPH;
    hipLaunchKernelGGL(fwd_kernel, dim3(grid), dim3(NTHR), LDS_BYTES, stream, a);
#else
    for (int p = 0; p < NPH; ++p) { a.ph_lo = p; a.ph_hi = p + 1; hipLaunchKernelGGL(fwd_kernel, dim3(grid), dim3(NTHR), LDS_BYTES, stream, a); }
#endif
}
```

```cpp
#include <hip/hip_runtime.h>
#include <cstdio>
#include <cstdint>

#define GAS __attribute__((address_space(1)))
#define LAS __attribute__((address_space(3)))
typedef unsigned short bf16;
typedef float f32x2 __attribute__((ext_vector_type(2)));
typedef float f32x4 __attribute__((ext_vector_type(4)));
typedef float f32x16 __attribute__((ext_vector_type(16)));
typedef short bf16x8 __attribute__((ext_vector_type(8)));
typedef short s16x4 __attribute__((ext_vector_type(4)));
typedef unsigned u32x2 __attribute__((ext_vector_type(2)));
typedef unsigned u32x4 __attribute__((ext_vector_type(4)));
typedef int v8i_t __attribute__((ext_vector_type(8)));

constexpr int NB = 4, SEQ = 4096, T = NB * SEQ, D = 2048, HD = 128, NH = 8, INC = 7168, NE = 64, FE = 512, TOPK = 8;
constexpr float EPS = 1e-6f;
constexpr float LOG2E = 1.4426950408889634f;
constexpr float RSQ_HD = 0.08838834764831845f;
constexpr int NWAVES = 8, NTHR = 512;
#ifndef DUP_PHASE
#define DUP_PHASE -1
#endif
constexpr int NPH = 9;

constexpr size_t MiB = 1u << 20;
constexpr size_t WS_CTL = 0, CTL_ZERO_BYTES = 1 * MiB;
constexpr size_t WS_MOD = 1 * MiB;
constexpr size_t WS_META = WS_MOD + 512 * 1024;
constexpr size_t WS_ROPE = 2 * MiB;
constexpr size_t WS_LTOK = 4 * MiB;
constexpr size_t WS_LW = 8 * MiB;
constexpr size_t WS_WIN = 12 * MiB;
constexpr size_t WS_WOUT = 40 * MiB;
constexpr size_t WS_WD = 48 * MiB;
constexpr size_t WS_ACT = 178 * MiB;
constexpr size_t WS_BIG = 338 * MiB;
constexpr size_t WS_WGU = WS_BIG;
constexpr size_t WS_H1 = WS_BIG + 260 * MiB;
constexpr size_t WS_U = WS_BIG + 324 * MiB;
constexpr size_t WS_OUT = WS_BIG;
constexpr size_t WS_WR = WS_BIG + 576 * MiB;
constexpr size_t WS_END = WS_WR + 1 * MiB;
constexpr int SH_POS0 = 147456;
static_assert(WS_WGU + (size_t)65 * 1024 * 2048 * 2 <= WS_H1 && WS_H1 + (size_t)T * D * 2 <= WS_U && WS_U + (size_t)T * INC * 2 <= WS_WR, "ws map");
static_assert(WS_WD + (size_t)65 * 2048 * 512 * 2 <= WS_ACT && WS_ACT + (size_t)163840 * 512 * 2 <= WS_BIG && WS_OUT + (size_t)147456 * 2048 * 2 <= WS_WR, "ws map");
constexpr int CW_BAR = 1024, CW_QHEAD = 16384, CW_CNT = 8256, CW_CVQ = 20480;

constexpr int SCR_BYTES = 147456;
constexpr int LDSCTL_OFF = SCR_BYTES;
constexpr int STASH_OFF = SCR_BYTES + 1024;
constexpr int LDS_BYTES = STASH_OFF + 8192;

#define LDS_WAIT() asm volatile("s_waitcnt lgkmcnt(0)" ::: "memory")
#define VM_WAIT() asm volatile("s_waitcnt vmcnt(0)" ::: "memory")
#define SBAR() __builtin_amdgcn_sched_barrier(0)
typedef __bf16 bf16x2_t __attribute__((ext_vector_type(2)));
__device__ __forceinline__ unsigned cvtpk(float lo, float hi) { const f32x2 v = {lo, hi}; const bf16x2_t r = __builtin_convertvector(v, bf16x2_t); return __builtin_bit_cast(unsigned, r); }
__device__ __forceinline__ unsigned pk_fp8x4(float a, float b, float c, float d) { int w = 0; w = __builtin_amdgcn_cvt_pk_fp8_f32(a, b, w, false); w = __builtin_amdgcn_cvt_pk_fp8_f32(c, d, w, true); return (unsigned)w; }
__device__ __forceinline__ float bf2f(unsigned short b) { return __uint_as_float(((unsigned)b) << 16); }
__device__ __forceinline__ float bflo(unsigned w) { return __uint_as_float(w << 16); }
__device__ __forceinline__ float bfhi(unsigned w) { return __uint_as_float(w & 0xffff0000u); }
__device__ __forceinline__ float wave_sum(float v) {
#pragma unroll
    for (int o = 1; o < 64; o <<= 1) v += __shfl_xor(v, o);
    return v;
}
__device__ __forceinline__ int lane_now() { int l; asm volatile("v_mbcnt_lo_u32_b32 %0, -1, 0\n\tv_mbcnt_hi_u32_b32 %0, -1, %0" : "=v"(l)); return l; }
#define TIDX (g_wv * 64 + lane_now())
__device__ __forceinline__ float fast_rcp(float x) { return __builtin_amdgcn_rcpf(x); }
__device__ __forceinline__ float fast_exp2(float x) { return __builtin_amdgcn_exp2f(x); }
__device__ __forceinline__ float silu_f(float x) { return x * fast_rcp(1.0f + fast_exp2(-x * LOG2E)); }

#define XB_TMO      128
#define XB_XCNT(j)  (256  + 64 * (j))
#define XB_XSUB(j)  (1280 + 64 * (j))
#define XB_XGEN(j)  (2304 + 64 * (j))
#define XB_TOP      3328
#define XB_TOPGEN   3392
#define XCD_BAR_WORDS 3456
#define XB_SPIN_CAP (1u << 18)
__device__ __forceinline__ unsigned xb_ld(unsigned* p)              { return __hip_atomic_load(p, __ATOMIC_RELAXED, __HIP_MEMORY_SCOPE_AGENT); }
__device__ __forceinline__ unsigned xb_add(unsigned* p, unsigned v) { return __hip_atomic_fetch_add(p, v, __ATOMIC_RELAXED, __HIP_MEMORY_SCOPE_AGENT); }
__device__ __forceinline__ unsigned xb_xcc_id() { return (unsigned)__builtin_amdgcn_s_getreg((3 << 11) | 20) & 0xFu; }
#define XB_SPIN(cond, bar) do { unsigned _sp = 0; while (cond) { __builtin_amdgcn_s_sleep(1); \
    if ((++_sp & 255u) == 0u) { if (xb_ld(&(bar)[XB_TMO])) break; if (_sp > XB_SPIN_CAP) { atomicAdd(&(bar)[XB_TMO], 1u); break; } } } } while (0)
struct XcdBarrier { unsigned* bar; unsigned x; volatile LAS unsigned* st; };
__device__ __forceinline__ XcdBarrier xcd_barrier_post(unsigned* bar, volatile LAS unsigned* st, const int g_wv) {
    XcdBarrier b; b.bar = bar; b.x = xb_xcc_id(); b.st = st;
    if (TIDX == 0) (void)xb_add(&bar[XB_XCNT(b.x)], 1u);
    return b;
}
__device__ __forceinline__ void xcd_barrier_complete(unsigned* bar, unsigned x, unsigned& nloc, unsigned& nx) {
    const unsigned G = gridDim.x * gridDim.y * gridDim.z;
    unsigned sum, cnt, mine, sp = 0u;
    for (;;) {
        sum = 0u; cnt = 0u; mine = 0u;
#pragma unroll
        for (unsigned j = 0; j < 16; ++j) { const unsigned c = xb_ld(&bar[XB_XCNT(j)]); sum += c; cnt += (c > 0u) ? 1u : 0u; mine = (j == x) ? c : mine; }
        if (sum == G) break;
        __builtin_amdgcn_s_sleep(1);
        if ((++sp & 255u) == 0u) { if (xb_ld(&bar[XB_TMO])) break; if (sp > XB_SPIN_CAP) { atomicAdd(&bar[XB_TMO], 1u); break; } }
    }
    nloc = mine > 0u ? mine : 1u; nx = cnt > 0u ? cnt : 1u;
}
__device__ __forceinline__ void xcd_barrier(const XcdBarrier& b, const int g_wv) {
    asm volatile("s_waitcnt vmcnt(0)" ::: "memory");
    __syncthreads();
    if (TIDX == 0) {
        unsigned* bar = b.bar;
        __builtin_amdgcn_s_waitcnt(0);
        unsigned nloc = b.st[0], nx = b.st[1];
        if (nloc == 0u) { xcd_barrier_complete(bar, b.x, nloc, nx); b.st[0] = nloc; b.st[1] = nx; }
        const unsigned old = xb_add(&bar[XB_XSUB(b.x)], 1u);
        const unsigned gen = old / nloc;
        if (old + 1u == (gen + 1u) * nloc) {
            __builtin_amdgcn_fence(__ATOMIC_RELEASE, "agent");
            asm volatile("s_waitcnt vmcnt(0)" ::: "memory");
            const unsigned og = xb_add(&bar[XB_TOP], 1u);
            const unsigned tg = og / nx;
            if (og + 1u == (tg + 1u) * nx) xb_add(&bar[XB_TOPGEN], 1u);
            else XB_SPIN(xb_ld(&bar[XB_TOPGEN]) == tg, bar);
            __builtin_amdgcn_fence(__ATOMIC_ACQUIRE, "agent");
            xb_add(&bar[XB_XGEN(b.x)], 1u);
            asm volatile("s_waitcnt vmcnt(0)" ::: "memory");
        } else {
            XB_SPIN(xb_ld(&bar[XB_XGEN(b.x)]) == gen, bar);
            __builtin_amdgcn_fence(__ATOMIC_ACQUIRE, "agent");
            asm volatile("s_waitcnt vmcnt(0)" ::: "memory");
        }
    }
    __syncthreads();
}

struct Args { const float* in[20]; float* out; unsigned char* ws; int ph_lo, ph_hi; };
enum { I_X = 0, I_C, I_WADA, I_BADA, I_N1G, I_WIN, I_RGN, I_WOUT, I_N2G, I_WR, I_RB, I_WG, I_WU, I_WDN, I_SG, I_SU, I_SD, I_WAF, I_BAF, I_NFG };

__constant__ float c_inv_freq[64] = {
1.0f, 0.865964353f, 0.749894202f, 0.649381638f, 0.562341332f, 0.486967534f, 0.421696514f, 0.365174115f, 0.316227764f, 0.273841977f, 0.237137377f, 0.2053525f, 0.177827939f, 0.153992653f, 0.133352146f, 0.115478195f,
0.100000001f, 0.0865964293f, 0.0749894232f, 0.0649381652f, 0.0562341325f, 0.0486967526f, 0.0421696492f, 0.0365174115f, 0.0316227749f, 0.0273841955f, 0.0237137377f, 0.0205352511f, 0.0177827943f, 0.0153992651f, 0.013335214f, 0.0115478197f,
0.00999999978f, 0.00865964312f, 0.00749894232f, 0.00649381615f, 0.00562341325f, 0.00486967526f, 0.00421696482f, 0.00365174119f, 0.00316227763f, 0.00273841969f, 0.00237137382f, 0.00205352507f, 0.00177827943f, 0.00153992651f, 0.00133352145f, 0.00115478202f,
0.00100000005f, 0.000865964335f, 0.000749894185f, 0.000649381604f, 0.000562341302f, 0.000486967532f, 0.000421696517f, 0.000365174114f, 0.000316227757f, 0.000273841957f, 0.00023713737f, 0.00020535251f, 0.00017782794f, 0.00015399266f, 0.00013335215f, 0.0001154782f };

template <int MODE> __device__ __forceinline__ int cvt_orow(int n) {
    if (MODE == 1) { const int grp = n >> 10; if (grp == 3 || grp == 4) { const int d = n & 127; return (n & ~127) + 2 * (d & 63) + (d >> 6); } return n; }
    if (MODE == 2) return ((n >> 7) << 8) + (n & 127);
    if (MODE == 3) return ((n >> 7) << 8) + 128 + (n & 127);
    return n;
}
template <int MODE> __device__ __forceinline__ void cvt_item(const float* W, int ldw, int k0, int n0, bf16* dst, int ldd, LAS float* scr, int lane) {
    const int n4 = lane & 15, kr = lane >> 4;
    f32x4 v[16];
#pragma unroll
    for (int i = 0; i < 16; ++i) v[i] = __builtin_nontemporal_load((const GAS f32x4*)(W + (size_t)(k0 + 4 * i + kr) * ldw + n0 + 4 * n4));
#pragma unroll
    for (int i = 0; i < 16; ++i) { LAS float* s = scr + (4 * i + kr) * 65 + 4 * n4; s[0] = v[i].x; s[1] = v[i].y; s[2] = v[i].z; s[3] = v[i].w; }
    LDS_WAIT(); asm volatile("" ::: "memory");
    const int kg = lane & 7, ns = lane >> 3;
#pragma unroll
    for (int j = 0; j < 8; ++j) { const int n = ns + 8 * j; const LAS float* s = scr + (8 * kg) * 65 + n;
        u32x4 o; o.x = cvtpk(s[0], s[65]); o.y = cvtpk(s[2 * 65], s[3 * 65]); o.z = cvtpk(s[4 * 65], s[5 * 65]); o.w = cvtpk(s[6 * 65], s[7 * 65]);
        *(GAS u32x4*)(dst + (size_t)cvt_orow<MODE>(n0 + n) * ldd + k0 + 8 * kg) = o; }
    LDS_WAIT(); asm volatile("" ::: "memory");
}
constexpr int CV_I0 = 32 * 112, CV_I1 = 32 * 32, CV_I2 = 64 * 32 * 8, CV_I4 = 64 * 8 * 32, CV_I5 = 32 * 8, CV_I7 = 8 * 32;
constexpr int CV_EARLY = CV_I0 + CV_I1, CV_SPLIT = CV_I0 + CV_I1 + 2 * CV_I2, CV_NIT = CV_I0 + CV_I1 + 2 * CV_I2 + CV_I4 + 2 * CV_I5 + CV_I7;
constexpr float WSCALE = 64.0f, ASCALE = 16.0f;
template <bool F8>
__device__ __forceinline__ void cvt_run(unsigned char* ws, LAS unsigned char* lds, const int g_wv, const int lo, const int hi, const int wg_local = 0) {
    const int tid = TIDX, lane = tid & 63, wave = g_wv, G = gridDim.x, bx = blockIdx.x;
    const volatile LAS unsigned long long* ptab = (const volatile LAS unsigned long long*)(lds + LDSCTL_OFF + 256);
    {
        LAS float* scr = (LAS float*)(lds + wave * 16640);
        const int gw = wg_local ? wave : bx * NWAVES + wave, NGW = wg_local ? NWAVES : G * NWAVES;
        bf16* Win = (bf16*)(ws + WS_WIN); bf16* Wout = (bf16*)(ws + WS_WOUT); unsigned char* Wgu8 = ws + WS_WGU; unsigned char* Wd8 = ws + WS_WD;
        constexpr int I0 = CV_I0, I1 = CV_I1, I2 = CV_I2, I4 = CV_I4, I5 = CV_I5; const int NIT = hi;
#define CVT_PTR(i_) ((const float*)(uintptr_t)ptab[i_])
#define CVT_DEC(it_, W_, dst_, ldw_, ldd_, k0_, n0_, mode_) do { int r = (it_); \
            if (r < I0) { W_ = CVT_PTR(0); ldw_ = INC; k0_ = 64 * (r / 112); n0_ = 64 * (r % 112); dst_ = Win; ldd_ = D; mode_ = 1; } \
            else if ((r -= I0) < I1) { W_ = CVT_PTR(1); ldw_ = D; k0_ = 64 * (r / 32); n0_ = 64 * (r % 32); dst_ = Wout; ldd_ = D; mode_ = 0; } \
            else if ((r -= I1) < I2) { const int e = r >> 8, q = r & 255; W_ = CVT_PTR(2) + (size_t)e * D * FE; ldw_ = FE; k0_ = 64 * (q >> 3); n0_ = 64 * (q & 7); dst_ = (bf16*)(Wgu8 + (size_t)e * 1024 * D); ldd_ = D; mode_ = 2; } \
            else if ((r -= I2) < I2) { const int e = r >> 8, q = r & 255; W_ = CVT_PTR(3) + (size_t)e * D * FE; ldw_ = FE; k0_ = 64 * (q >> 3); n0_ = 64 * (q & 7); dst_ = (bf16*)(Wgu8 + (size_t)e * 1024 * D); ldd_ = D; mode_ = 3; } \
            else if ((r -= I2) < I4) { const int e = r >> 8, q = r & 255; W_ = CVT_PTR(4) + (size_t)e * FE * D; ldw_ = D; k0_ = 64 * (q >> 5); n0_ = 64 * (q & 31); dst_ = (bf16*)(Wd8 + (size_t)e * D * FE); ldd_ = FE; mode_ = 0; } \
            else if ((r -= I4) < I5) { W_ = CVT_PTR(5); ldw_ = FE; k0_ = 64 * (r >> 3); n0_ = 64 * (r & 7); dst_ = (bf16*)(Wgu8 + (size_t)64 * 1024 * D); ldd_ = D; mode_ = 2; } \
            else if ((r -= I5) < I5) { W_ = CVT_PTR(6); ldw_ = FE; k0_ = 64 * (r >> 3); n0_ = 64 * (r & 7); dst_ = (bf16*)(Wgu8 + (size_t)64 * 1024 * D); ldd_ = D; mode_ = 3; } \
            else { r -= I5; W_ = CVT_PTR(7); ldw_ = D; k0_ = 64 * (r >> 5); n0_ = 64 * (r & 31); dst_ = (bf16*)(Wd8 + (size_t)64 * D * FE); ldd_ = FE; mode_ = 0; } } while (0)
        const int n4 = lane & 15, kr = lane >> 4, kg = lane & 7, ns = lane >> 3;
#define CVT_LOAD(V_, W_, ldw_, k0_, n0_) do { _Pragma("unroll") for (int i = 0; i < 16; ++i) V_[i] = __builtin_nontemporal_load((const GAS f32x4*)((W_) + (size_t)((k0_) + (F8 ? 16 * (i >> 2) + 4 * kr + (i & 3) : 8 * (i >> 1) + 2 * kr + (i & 1))) * (ldw_) + (n0_) + 4 * n4)); } while (0)
#define CVT_STORE(V_, dst_, ldd_, k0_, n0_, mode_) do { LAS unsigned* s32 = (LAS unsigned*)scr; \
            if constexpr (F8) { \
            _Pragma("unroll") for (int j = 0; j < 4; ++j) { LAS unsigned* s = s32 + (4 * n4) * 17 + 4 * j + kr; \
                s[0] = pk_fp8x4(V_[4 * j].x * WSCALE, V_[4 * j + 1].x * WSCALE, V_[4 * j + 2].x * WSCALE, V_[4 * j + 3].x * WSCALE); s[17] = pk_fp8x4(V_[4 * j].y * WSCALE, V_[4 * j + 1].y * WSCALE, V_[4 * j + 2].y * WSCALE, V_[4 * j + 3].y * WSCALE); \
                s[34] = pk_fp8x4(V_[4 * j].z * WSCALE, V_[4 * j + 1].z * WSCALE, V_[4 * j + 2].z * WSCALE, V_[4 * j + 3].z * WSCALE); s[51] = pk_fp8x4(V_[4 * j].w * WSCALE, V_[4 * j + 1].w * WSCALE, V_[4 * j + 2].w * WSCALE, V_[4 * j + 3].w * WSCALE); } \
            LDS_WAIT(); asm volatile("" ::: "memory"); \
            _Pragma("unroll") for (int j = 0; j < 4; ++j) { const int n = (n0_) + (lane >> 2) + 16 * j; const LAS unsigned* s = s32 + ((lane >> 2) + 16 * j) * 17 + 4 * (lane & 3); \
                int orow = n; if ((mode_) == 1) { const int grp = n >> 10; if (grp == 3 || grp == 4) { const int dd = n & 127; orow = (n & ~127) + 2 * (dd & 63) + (dd >> 6); } } \
                else if ((mode_) >= 2) orow = ((n >> 7) << 8) + (n & 127) + ((mode_) == 3 ? 128 : 0); \
                u32x4 o; o.x = s[0]; o.y = s[1]; o.z = s[2]; o.w = s[3]; \
                __builtin_nontemporal_store(o, (GAS u32x4*)((unsigned char*)(dst_) + (size_t)orow * (ldd_) + (k0_) + 16 * (lane & 3))); } \
            } else { \
            _Pragma("unroll") for (int j = 0; j < 8; ++j) { LAS unsigned* s = s32 + (4 * n4) * 33 + 4 * j + kr; \
                s[0] = cvtpk(V_[2 * j].x, V_[2 * j + 1].x); s[33] = cvtpk(V_[2 * j].y, V_[2 * j + 1].y); s[66] = cvtpk(V_[2 * j].z, V_[2 * j + 1].z); s[99] = cvtpk(V_[2 * j].w, V_[2 * j + 1].w); } \
            LDS_WAIT(); asm volatile("" ::: "memory"); \
            _Pragma("unroll") for (int j = 0; j < 8; ++j) { const int n = (n0_) + ns + 8 * j; const LAS unsigned* s = s32 + (ns + 8 * j) * 33 + 4 * kg; \
                int orow = n; if ((mode_) == 1) { const int grp = n >> 10; if (grp == 3 || grp == 4) { const int dd = n & 127; orow = (n & ~127) + 2 * (dd & 63) + (dd >> 6); } } \
                else if ((mode_) >= 2) orow = ((n >> 7) << 8) + (n & 127) + ((mode_) == 3 ? 128 : 0); \
                u32x4 o; o.x = s[0]; o.y = s[1]; o.z = s[2]; o.w = s[3]; \
                __builtin_nontemporal_store(o, (GAS u32x4*)((dst_) + (size_t)orow * (ldd_) + (k0_) + 8 * kg)); } \
            } \
            LDS_WAIT(); asm volatile("" ::: "memory"); } while (0)
        f32x4 va[16], vb[16];
#define CVT_L(V_, it_) do { const float* W_ = nullptr; bf16* ds_ = nullptr; int lw_ = 0, ld_ = 0, k_ = 0, n_ = 0, mo_ = 0; CVT_DEC(it_, W_, ds_, lw_, ld_, k_, n_, mo_); (void)ds_; (void)ld_; (void)mo_; CVT_LOAD(V_, W_, lw_, k_, n_); } while (0)
#define CVT_S(V_, it_) do { const float* W_ = nullptr; bf16* ds_ = nullptr; int lw_ = 0, ld_ = 0, k_ = 0, n_ = 0, mo_ = 0; CVT_DEC(it_, W_, ds_, lw_, ld_, k_, n_, mo_); (void)W_; (void)lw_; CVT_STORE(V_, ds_, ld_, k_, n_, mo_); } while (0)
        f32x4 vc[16];
        int it = lo + gw;
        if (it < NIT) { CVT_L(va, it); if (it + NGW < NIT) CVT_L(vb, it + NGW);
            for (;;) {
                if (it + 2 * NGW < NIT) CVT_L(vc, it + 2 * NGW);
                CVT_S(va, it); it += NGW; if (it >= NIT) break;
                if (it + 2 * NGW < NIT) CVT_L(va, it + 2 * NGW);
                CVT_S(vb, it); it += NGW; if (it >= NIT) break;
                if (it + 2 * NGW < NIT) CVT_L(vb, it + 2 * NGW);
                CVT_S(vc, it); it += NGW; if (it >= NIT) break;
            }
        }
#undef CVT_L
#undef CVT_S
#undef CVT_DEC
#undef CVT_PTR
#undef CVT_LOAD
#undef CVT_STORE
    }
}

__device__ __forceinline__ void p0_prologue(const Args& a, LAS unsigned char* lds, const int g_wv) {
    const int tid = TIDX, lane = tid & 63, wave = g_wv, G = gridDim.x, bx = blockIdx.x;
    unsigned char* ws = a.ws;
    float* modv = (float*)(ws + WS_MOD);
    {
        LAS float* cs = (LAS float*)lds;
        LAS float* red = (LAS float*)(lds + 32768);
        for (int i = tid; i < 4 * D; i += NTHR) cs[i] = silu_f(a.in[I_C][i]);
        __syncthreads();
        for (int it = bx; it < 256; it += G) {
            const float* W; int ldw, col; const float* bias;
            if (it < 192) { W = a.in[I_WADA]; ldw = 6 * D; col = it * 64; bias = a.in[I_BADA]; }
            else { W = a.in[I_WAF]; ldw = 2 * D; col = (it - 192) * 64; bias = a.in[I_BAF]; }
            float a0 = 0.f, a1 = 0.f, a2 = 0.f, a3 = 0.f;
            const int kbeg = wave * 256;
#pragma unroll 4
            for (int k4 = 0; k4 < 64; ++k4) {
                const int k = kbeg + 4 * k4;
                float wv[4];
#pragma unroll
                for (int c = 0; c < 4; ++c) wv[c] = W[(size_t)(k + c) * ldw + col + lane];
                const f32x4 c0 = *(const LAS f32x4*)(cs + k), c1 = *(const LAS f32x4*)(cs + D + k), c2 = *(const LAS f32x4*)(cs + 2 * D + k), c3 = *(const LAS f32x4*)(cs + 3 * D + k);
                a0 += c0.x * wv[0] + c0.y * wv[1] + c0.z * wv[2] + c0.w * wv[3];
                a1 += c1.x * wv[0] + c1.y * wv[1] + c1.z * wv[2] + c1.w * wv[3];
                a2 += c2.x * wv[0] + c2.y * wv[1] + c2.z * wv[2] + c2.w * wv[3];
                a3 += c3.x * wv[0] + c3.y * wv[1] + c3.z * wv[2] + c3.w * wv[3];
            }
            red[(wave * 4 + 0) * 64 + lane] = a0; red[(wave * 4 + 1) * 64 + lane] = a1; red[(wave * 4 + 2) * 64 + lane] = a2; red[(wave * 4 + 3) * 64 + lane] = a3;
            __syncthreads();
            if (tid < 256) { const int b = tid >> 6; float s = bias[col + lane];
#pragma unroll
                for (int w = 0; w < 8; ++w) s += red[(w * 4 + b) * 64 + lane];
                modv[b * 16384 + it * 64 + lane] = s; }
            __syncthreads();
        }
    }
    {
        float* rope = (float*)(ws + WS_ROPE);
        for (int i = bx * NTHR + tid; i < SEQ * 64; i += G * NTHR) {
            const int pos = i >> 6, f = i & 63;
            const double rev = (double)pos * (double)c_inv_freq[f] * 0.15915494309189533577;
            const float fr = (float)(rev - __builtin_rint(rev));
            f32x2 o; o.x = __builtin_amdgcn_cosf(fr); o.y = __builtin_amdgcn_sinf(fr);
            *(GAS f32x2*)(rope + 2 * (size_t)i) = o;
        }
    }
    {
        bf16* Wrh = (bf16*)(ws + WS_WR); bf16* Wrl = Wrh + NE * D;
        for (int i = bx * NTHR + tid; i < NE * (D / 8); i += G * NTHR) {
            const int ln = i & 63, nt = (i >> 6) & 3, ks = i >> 8;
            const int e = nt * 16 + (ln & 15), k0 = 32 * ks + 8 * (ln >> 4); float v[8];
#pragma unroll
            for (int j = 0; j < 8; ++j) v[j] = a.in[I_WR][(size_t)(k0 + j) * NE + e];
            u32x4 hw, lw;
#pragma unroll
            for (int j = 0; j < 4; ++j) { const unsigned hp = cvtpk(v[2 * j], v[2 * j + 1]); ((unsigned*)&hw)[j] = hp; ((unsigned*)&lw)[j] = cvtpk(v[2 * j] - bflo(hp), v[2 * j + 1] - bfhi(hp)); }
            *(GAS u32x4*)(Wrh + (size_t)i * 8) = hw; *(GAS u32x4*)(Wrl + (size_t)i * 8) = lw;
        }
    }
    cvt_run<true>(a.ws, lds, g_wv, 0, CV_EARLY);
}

template <bool F8>
__device__ __forceinline__ void norm_rows_bf16(const float* X, const float* gain, const float* modv, int off_shift, int off_scale, bf16* Hout, const int g_wv) {
    const int tid = TIDX, lane = tid & 63, wave = g_wv;
    const int gw = blockIdx.x * NWAVES + wave, NGW = gridDim.x * NWAVES;
    f32x4 A[8], B[8]; int curb = -1;
    for (int row = (int)((long)gw * T / NGW), rowe = (int)((long)(gw + 1) * T / NGW); row < rowe; ++row) {
        const int b = row >> 12;
        if (b != curb) { curb = b;
#pragma unroll
            for (int j = 0; j < 8; ++j) { const int d = 4 * lane + 256 * j; const f32x4 g = *(const GAS f32x4*)(gain + d), sc = *(const GAS f32x4*)(modv + b * 16384 + off_scale + d);
                A[j] = g * (1.0f + sc); B[j] = *(const GAS f32x4*)(modv + b * 16384 + off_shift + d); } }
        const GAS f32x4* xr = (const GAS f32x4*)(X + (size_t)row * D) + lane;
        f32x4 v[8]; float ss = 0.f;
#pragma unroll
        for (int j = 0; j < 8; ++j) { v[j] = __builtin_nontemporal_load(xr + 64 * j); ss += (v[j].x * v[j].x + v[j].y * v[j].y) + (v[j].z * v[j].z + v[j].w * v[j].w); }
        const float rstd = __builtin_amdgcn_rsqf(wave_sum(ss) * (1.0f / D) + EPS);
        if constexpr (F8) { GAS unsigned* o4 = (GAS unsigned*)((unsigned char*)Hout + (size_t)row * D) + lane;
#pragma unroll
            for (int j = 0; j < 8; ++j) { const f32x4 h = v[j] * rstd * A[j] + B[j]; o4[64 * j] = pk_fp8x4(h.x, h.y, h.z, h.w); }
        } else { GAS u32x2* o8 = (GAS u32x2*)(Hout + (size_t)row * D) + lane;
#pragma unroll
            for (int j = 0; j < 8; ++j) { const f32x4 h = v[j] * rstd * A[j] + B[j]; u32x2 w; w.x = cvtpk(h.x, h.y); w.y = cvtpk(h.z, h.w); o8[64 * j] = w; } }
    }
}

namespace pg8 {
constexpr int BM = 256, BK = 64, HALF = 128, HTB = HALF * BK * 2, STAGE_BYTES = 8 * HTB, NXCD = 8, WGM = 8;
__host__ __device__ __forceinline__ int lds_byte(int r, int c) { const int st = (r >> 4) * 2 + (c >> 5), rr = r & 15, cc = c & 31, ob = rr * 64 + cc * 2; return st * 1024 + (ob ^ (((ob >> 9) & 1) << 5)); }
__host__ __device__ __forceinline__ void stage_rc(int b, int& R, int& C) { const int st = b / 1024, sb = b % 1024, swz = sb ^ (((sb >> 9) & 1) << 5); R = (st >> 1) * 16 + swz / 64; C = (st & 1) * 32 + (swz % 64) / 2; }
__host__ __device__ __forceinline__ int perm32(int rho) { const int n = rho >> 4, i = rho & 15; return 8 * (i >> 2) + 4 * n + (i & 3); }

struct DUnit { int pm, pn; };
struct DenseOrder {
    typedef DUnit Unit;
    int nM, nN, nwg, G, c, K, i0, cnt;
    __device__ void init(int M, int N, int K_, int G_, int c_) { nM = M / BM; nN = N / BM; nwg = nM * nN; G = G_; c = c_; K = K_; i0 = 0; cnt = 1 << 30; }
    __device__ bool next(int i, DUnit& u) const {
        if (i >= cnt) return false;
        const long L = (long)(i + i0) * G + c; if (L >= nwg) return false;
        int wgid = (int)L; { const int q = nwg / NXCD, r = nwg % NXCD, xcd = wgid % NXCD, off = wgid / NXCD; wgid = (xcd < r ? xcd * (q + 1) : r * (q + 1) + (xcd - r) * q) + off; }
        const int nig = WGM * nN, gid = wgid / nig, fm = gid * WGM, gsz = (nM - fm) < WGM ? (nM - fm) : WGM;
        u.pm = fm + ((wgid % nig) % gsz); u.pn = (wgid % nig) / gsz; return true;
    }
    __device__ __forceinline__ void a_offs(const DUnit& u, int tid, unsigned (&ao)[2][2]) const {
#pragma unroll
        for (int i = 0; i < 2; ++i) { int R, C; stage_rc(tid * 16 + i * 8192, R, C);
#pragma unroll
            for (int h = 0; h < 2; ++h) ao[h][i] = (unsigned)(((u.pm * BM + h * HALF + R) * K + C) * 2); }
    }
    __device__ __forceinline__ size_t b_off(const DUnit& u) const { return (size_t)u.pn * BM * K * 2; }
    static constexpr bool LANE_CONST = true;
    __device__ __forceinline__ unsigned a_base(const DUnit& u) const { return (unsigned)u.pm * (unsigned)(BM * K * 2); }
    __device__ __forceinline__ void a_lane(int tid, unsigned (&vo)[2]) const {
#pragma unroll
        for (int i = 0; i < 2; ++i) { int R, C; stage_rc(tid * 16 + i * 8192, R, C); vo[i] = (unsigned)((R * K + C) * 2); }
    }
};

typedef int v4i_t __attribute__((ext_vector_type(4)));
template <bool F8> struct FragT { struct T { bf16x8 kh[2]; }; };
template <> struct FragT<true> { struct T { v8i_t v; }; };
template <class Sched, class Epi, bool ALIGN_EPI, bool SP2, int PROBE = 0>
__device__ __forceinline__ void gemm_phase(LAS unsigned char* lds, const char* gA, const char* gB, const int K, const Sched& S, const Epi& E, const int g_wv) {
    static_assert(SP2, "only the two-phase-per-half schedule is kept");
    const int tid = TIDX, wid = g_wv, lane = tid & 63, wr = wid >> 2, wc = wid & 3, fr = lane & 15, fq = lane >> 4;
    const int nt = K / BK;
    constexpr bool LEAN = Epi::FP8, LANEC = LEAN && Sched::LANE_CONST, STASH = LEAN && !Sched::LANE_CONST;
    unsigned voffB[2];
#pragma unroll
    for (int i = 0; i < 2; ++i) { int R, C; stage_rc(tid * 16 + i * 8192, R, C);
        const int Rb = (Epi::PERM == 1) ? ((R & ~31) + perm32(R & 31)) : (Epi::PERM == 3) ? (64 * (R >> 5) + 16 * ((R >> 2) & 3) + 4 * ((R >> 4) & 1) + (R & 3)) : R;
        voffB[i] = (unsigned)(Rb * K + C) * 2u; }
    const size_t hstepB = (Epi::PERM == 3) ? (size_t)8 * K * 2 : (size_t)HALF * K * 2;
    const size_t kstep = (size_t)(BK * 2);
    const size_t hstep = (size_t)HALF * K * 2;
    const unsigned ldsw = (unsigned)wid * 1024u;
    const int aoff = lds_byte(wr * 64 + fr, fq * 8), boff = lds_byte(wc * 32 + fr, fq * 8);
#define PG8_SA(b, h) (((b) * 2 + (h)) * HTB)
#define PG8_SB(b, h) ((4 + (b) * 2 + (h)) * HTB)
#define PG8_STAGE_B(bufoff, gbase, h) do { const char* _bb = (const char*)(gbase) + (h) * hstepB; unsigned _lb = ldsw; asm volatile("" : "+s"(_bb), "+s"(_lb)); _Pragma("unroll") for (int _i = 0; _i < 2; ++_i) { \
        unsigned _o = voffB[_i]; asm volatile("" : "+v"(_o)); \
        __builtin_amdgcn_global_load_lds((const unsigned*)(_bb + _o), (LAS unsigned*)(lds + (bufoff) + _lb + _i * 8192), 16, 0, 0); } } while (0)
#define PG8_STAGE_A(bufoff, kb, AO, ABASE, h) do { const char* _ab = gA + (size_t)(kb) + (LANEC ? (ABASE) + (h) * hstep : (size_t)0); unsigned _lb = ldsw; asm volatile("" : "+s"(_ab), "+s"(_lb)); _Pragma("unroll") for (int _i = 0; _i < 2; ++_i) { \
        unsigned _o = LANEC ? voffA[_i] : (AO)[h][_i]; asm volatile("" : "+v"(_o)); \
        __builtin_amdgcn_global_load_lds((const unsigned*)(_ab + _o), (LAS unsigned*)(lds + (bufoff) + _lb + _i * 8192), 16, 0, 0); } } while (0)
#define PG8_LDA(dst, b, h) do { if constexpr (PROBE != 2) _Pragma("unroll") for (int m = 0; m < 4; ++m) { if constexpr (Epi::FP8) { { const v4i_t _lo = *(const LAS v4i_t*)(lds + PG8_SA(b, h) + aoff + m * 2048), _hi = *(const LAS v4i_t*)(lds + PG8_SA(b, h) + aoff + m * 2048 + 1024); dst[m].v = __builtin_shufflevector(_lo, _hi, 0, 1, 2, 3, 4, 5, 6, 7); } } \
        else { _Pragma("unroll") for (int k = 0; k < 2; ++k) dst[m].kh[k] = *(const LAS bf16x8*)(lds + PG8_SA(b, h) + aoff + m * 2048 + k * 1024); } } } while (0)
#define PG8_LDB(dst, b, h) do { if constexpr (PROBE != 2) _Pragma("unroll") for (int n = 0; n < 2; ++n) { if constexpr (Epi::FP8) { { const v4i_t _lo = *(const LAS v4i_t*)(lds + PG8_SB(b, h) + boff + n * 2048), _hi = *(const LAS v4i_t*)(lds + PG8_SB(b, h) + boff + n * 2048 + 1024); dst[n].v = __builtin_shufflevector(_lo, _hi, 0, 1, 2, 3, 4, 5, 6, 7); } } \
        else { _Pragma("unroll") for (int k = 0; k < 2; ++k) dst[n].kh[k] = *(const LAS bf16x8*)(lds + PG8_SB(b, h) + boff + n * 2048 + k * 1024); } } } while (0)
#define PG8_MMA(ai, bj, At, Bt) do { __builtin_amdgcn_s_setprio(1); if constexpr (PROBE != 1) _Pragma("unroll") for (int m = 0; m < 4; ++m) _Pragma("unroll") for (int n = 0; n < 2; ++n) { \
        if constexpr (Epi::FP8) acc[ai][bj][m][n] = __builtin_amdgcn_mfma_scale_f32_16x16x128_f8f6f4(Bt[n].v, At[m].v, acc[ai][bj][m][n], 0, 0, 0, 0, 0, 0); \
        else { _Pragma("unroll") for (int k = 0; k < 2; ++k) acc[ai][bj][m][n] = __builtin_amdgcn_mfma_f32_16x16x32_bf16(Bt[n].kh[k], At[m].kh[k], acc[ai][bj][m][n], 0, 0, 0); } } \
        _Pragma("unroll") for (int m = 0; m < 4; ++m) asm volatile("" : "+v"(acc[ai][bj][m][0]), "+v"(acc[ai][bj][m][1]));     \
        __builtin_amdgcn_s_setprio(0); } while (0)
#define PG8_WAIT_V(n) asm volatile("s_waitcnt vmcnt(" #n ")" ::: "memory")
#define PG8_WAIT_L(n) asm volatile("s_waitcnt lgkmcnt(" #n ")" ::: "memory")
#define PG8_BAR __builtin_amdgcn_s_barrier()
#define PG8_SCHED __builtin_amdgcn_sched_barrier(0)
#define PG8_STEP(KK1, KK2, KK3, PB2, PB3, AO2, AB2, HOOK2) do { \
            PG8_LDB(B0, 0, 0); PG8_LDB(B1, 0, 1); PG8_SCHED; PG8_LDA(At, 0, 0); PG8_STAGE_A(PG8_SA(1, 1), KK1, aoC, baseC, 1); \
            PG8_WAIT_V(8); PG8_WAIT_L(0); PG8_BAR; PG8_MMA(0, 0, At, B0); PG8_MMA(0, 1, At, B1); PG8_BAR; PG8_SCHED; \
            HOOK2; PG8_LDA(At, 0, 1); PG8_STAGE_B(PG8_SB(0, 0), PB2, 0); PG8_STAGE_B(PG8_SB(0, 1), PB2, 1); PG8_STAGE_A(PG8_SA(0, 0), KK2, AO2, AB2, 0); \
            PG8_WAIT_V(8); PG8_WAIT_L(0); PG8_BAR; PG8_MMA(1, 0, At, B0); PG8_MMA(1, 1, At, B1); PG8_BAR; PG8_SCHED; \
            PG8_LDB(B0, 1, 0); PG8_LDB(B1, 1, 1); PG8_SCHED; PG8_LDA(At, 1, 0); PG8_STAGE_A(PG8_SA(0, 1), KK2, AO2, AB2, 1); \
            PG8_WAIT_V(8); PG8_WAIT_L(0); PG8_BAR; PG8_MMA(0, 0, At, B0); PG8_MMA(0, 1, At, B1); PG8_BAR; PG8_SCHED; \
            PG8_LDA(At, 1, 1); PG8_STAGE_B(PG8_SB(1, 0), PB3, 0); PG8_STAGE_B(PG8_SB(1, 1), PB3, 1); PG8_STAGE_A(PG8_SA(1, 0), KK3, AO2, AB2, 0); \
            PG8_WAIT_V(8); PG8_WAIT_L(0); PG8_BAR; PG8_MMA(1, 0, At, B0); PG8_MMA(1, 1, At, B1); PG8_BAR; PG8_SCHED; } while (0)
    typename Sched::Unit cur, nxt; int ui = 0;
    if (!S.next(0, cur)) return;
    f32x4 acc[2][2][4][2];
#pragma unroll
    for (int a = 0; a < 2; ++a)
#pragma unroll
        for (int b = 0; b < 2; ++b)
#pragma unroll
            for (int m = 0; m < 4; ++m)
#pragma unroll
                for (int n = 0; n < 2; ++n) acc[a][b][m][n] = (f32x4){0.f, 0.f, 0.f, 0.f};
    typedef typename FragT<Epi::FP8>::T frag_t;
    frag_t At[4], B0[2], B1[2];
    unsigned aoC[2][2] = {{0u, 0u}, {0u, 0u}}, voffA[2] = {0u, 0u};
    unsigned baseC = 0, baseN = 0;
    if constexpr (LANEC) { S.a_lane(tid, voffA); baseC = S.a_base(cur); } else S.a_offs(cur, tid, aoC);
    const char* cB = gB + S.b_off(cur);
    PG8_STAGE_B(PG8_SB(0, 0), cB, 0); PG8_STAGE_B(PG8_SB(0, 1), cB, 1); PG8_STAGE_A(PG8_SA(0, 0), 0, aoC, baseC, 0); PG8_STAGE_A(PG8_SA(0, 1), 0, aoC, baseC, 1);
    if (wr == 1) PG8_BAR;
    PG8_WAIT_V(2); PG8_BAR;
    PG8_STAGE_B(PG8_SB(1, 0), cB + kstep, 0); PG8_STAGE_A(PG8_SA(1, 0), kstep, aoC, baseC, 0); PG8_STAGE_B(PG8_SB(1, 1), cB + kstep, 1);
    PG8_WAIT_V(6); PG8_BAR;
    for (;;) {
        const bool has_next = S.next(ui + 1, nxt);
        const char* nB = cB;
        unsigned aoN[2][2];
#pragma unroll
        for (int h = 0; h < 2; ++h)
#pragma unroll
            for (int i = 0; i < 2; ++i) aoN[h][i] = aoC[h][i];
        baseN = baseC;
        if (has_next) { nB = gB + S.b_off(nxt); if constexpr (LANEC) baseN = S.a_base(nxt); else S.a_offs(nxt, LEAN ? TIDX : tid, aoN); }
        if constexpr (STASH) *((LAS u32x4*)(lds + STASH_OFF) + TIDX) = (u32x4){aoN[0][0], aoN[0][1], aoN[1][0], aoN[1][1]};
#pragma unroll 1
        for (int t = 0; t < nt; t += 2) {
            const bool last = (t == nt - 2);
            const size_t k1 = (size_t)(t + 1) * kstep;
            const size_t k2 = last ? (size_t)0 : (size_t)(t + 2) * kstep, k3 = k2 + kstep;
            const char* b2 = last ? nB : cB + (size_t)(t + 2) * kstep; const char* b3 = b2 + kstep;
            const unsigned base2 = last ? baseN : baseC;
            unsigned ao2[2][2];
            if constexpr (STASH) {
                const u32x4 sv = *((const LAS u32x4*)(lds + STASH_OFF) + TIDX);
                PG8_STEP(k1, k2, k3, b2, b3, ao2, base2, (ao2[0][0] = last ? sv.x : aoC[0][0], ao2[0][1] = last ? sv.y : aoC[0][1], ao2[1][0] = last ? sv.z : aoC[1][0], ao2[1][1] = last ? sv.w : aoC[1][1]));
            } else {
#pragma unroll
                for (int h = 0; h < 2; ++h)
#pragma unroll
                    for (int i = 0; i < 2; ++i) ao2[h][i] = last ? aoN[h][i] : aoC[h][i];
                PG8_STEP(k1, k2, k3, b2, b3, ao2, base2, (void)0);
            }
        }
        if constexpr (STASH) { const u32x4 sv = *((const LAS u32x4*)(lds + STASH_OFF) + TIDX); aoC[0][0] = sv.x; aoC[0][1] = sv.y; aoC[1][0] = sv.z; aoC[1][1] = sv.w; }
        else {
#pragma unroll
            for (int h = 0; h < 2; ++h)
#pragma unroll
                for (int i = 0; i < 2; ++i) aoC[h][i] = aoN[h][i];
        }
        if constexpr (ALIGN_EPI) { if (wr == 0) PG8_BAR; }
        if constexpr (LEAN) { const int le = lane_now(); E(acc, cur, wr, wc, le & 15, le >> 4); }
        else E(acc, cur, wr, wc, fr, fq);
        if (!has_next) break;
#pragma unroll
        for (int a = 0; a < 2; ++a)
#pragma unroll
            for (int b = 0; b < 2; ++b)
#pragma unroll
                for (int m = 0; m < 4; ++m)
#pragma unroll
                    for (int n = 0; n < 2; ++n) acc[a][b][m][n] = (f32x4){0.f, 0.f, 0.f, 0.f};
        cur = nxt; cB = nB; baseC = baseN; ++ui;
        if constexpr (ALIGN_EPI) { if (wr == 1) PG8_BAR; }
    }
    PG8_WAIT_V(0);
    if constexpr (!ALIGN_EPI) { if (wr == 0) PG8_BAR; }
    PG8_BAR;
#undef PG8_SA
#undef PG8_SB
#undef PG8_STAGE_A
#undef PG8_STAGE_B
#undef PG8_LDA
#undef PG8_LDB
#undef PG8_MMA
#undef PG8_WAIT_V
#undef PG8_WAIT_L
#undef PG8_BAR
#undef PG8_SCHED
#undef PG8_STEP
}
}

struct EpiQKV {
    static constexpr int PERM = 1; static constexpr bool FP8 = true;
    bf16* U; const float* rope; int nostore;
    __device__ __forceinline__ void operator()(const f32x4 (&acc)[2][2][4][2], const pg8::DUnit& u, int wr, int wc, int fr, int fq) const {
        const int grp = u.pn >> 2;
        const int row0 = u.pm * 256 + wr * 64 + fr, col0 = u.pn * 256 + wc * 32 + 8 * fq;
        const float sc = ((grp == 0) ? (RSQ_HD * LOG2E) : ((grp == 4) ? RSQ_HD : 1.0f)) * (1.0f / WSCALE);
        const bool rot = (grp == 3) || (grp == 4);
        f32x4 cc[2][4][2];
#pragma unroll
        for (int ai = 0; ai < 2; ++ai)
#pragma unroll
            for (int m = 0; m < 4; ++m) { const int row = row0 + ai * 128 + m * 16; cc[ai][m][0] = (f32x4){1.f, 0.f, 1.f, 0.f}; cc[ai][m][1] = cc[ai][m][0];
                if (rot) { const float* rp = rope + ((size_t)(row & (SEQ - 1)) * 64 + 16 * wc + 4 * fq) * 2; cc[ai][m][0] = *(const GAS f32x4*)rp; cc[ai][m][1] = *(const GAS f32x4*)(rp + 4); } }
#pragma unroll
        for (int ai = 0; ai < 2; ++ai)
#pragma unroll
            for (int m = 0; m < 4; ++m) { const int row = row0 + ai * 128 + m * 16; bf16* rowp = U + (size_t)row * INC + col0;
                const f32x4 c0 = cc[ai][m][0], c1 = cc[ai][m][1];
#pragma unroll
                for (int bj = 0; bj < 2; ++bj) { f32x4 v0 = acc[ai][bj][m][0], v1 = acc[ai][bj][m][1];
                    if (rot) {
                        const f32x4 a = v0, b = v1;
                        v0.x = a.x * c0.x - a.y * c0.y; v0.y = a.x * c0.y + a.y * c0.x; v0.z = a.z * c0.z - a.w * c0.w; v0.w = a.z * c0.w + a.w * c0.z;
                        v1.x = b.x * c1.x - b.y * c1.y; v1.y = b.x * c1.y + b.y * c1.x; v1.z = b.z * c1.z - b.w * c1.w; v1.w = b.z * c1.w + b.w * c1.z;
                    }
                    v0 = v0 * sc; v1 = v1 * sc;
                    u32x4 w; w.x = cvtpk(v0.x, v0.y); w.y = cvtpk(v0.z, v0.w); w.z = cvtpk(v1.x, v1.y); w.w = cvtpk(v1.z, v1.w);
                    if (!nostore) *(GAS u32x4*)(rowp + bj * 128) = w; else asm volatile("" :: "v"(w)); } }
    }
};
struct EpiResid {
    static constexpr int PERM = 0; static constexpr bool FP8 = true;
    const float* X; float* X1; const float* modv;
    __device__ __forceinline__ void operator()(const f32x4 (&acc)[2][2][4][2], const pg8::DUnit& u, int wr, int wc, int fr, int fq) const {
        const int row0 = u.pm * 256 + wr * 64 + fr, col0 = u.pn * 256 + wc * 32 + 4 * fq, b = u.pm >> 4;
        f32x4 gv[2][2];
#pragma unroll
        for (int bj = 0; bj < 2; ++bj)
#pragma unroll
            for (int n = 0; n < 2; ++n) gv[bj][n] = *(const GAS f32x4*)(modv + b * 16384 + 4096 + col0 + bj * 128 + n * 16) * (1.0f / WSCALE);
#pragma unroll
        for (int ai = 0; ai < 2; ++ai) {
            f32x4 xv[4][2][2];
#pragma unroll
            for (int m = 0; m < 4; ++m) { const size_t off = (size_t)(row0 + ai * 128 + m * 16) * D + col0;
#pragma unroll
                for (int bj = 0; bj < 2; ++bj)
#pragma unroll
                    for (int n = 0; n < 2; ++n) xv[m][bj][n] = *(const GAS f32x4*)(X + off + bj * 128 + n * 16); }
#pragma unroll
            for (int m = 0; m < 4; ++m) { const size_t off = (size_t)(row0 + ai * 128 + m * 16) * D + col0;
#pragma unroll
                for (int bj = 0; bj < 2; ++bj)
#pragma unroll
                    for (int n = 0; n < 2; ++n) *(GAS f32x4*)(X1 + off + bj * 128 + n * 16) = xv[m][bj][n] + gv[bj][n] * acc[ai][bj][m][n]; }
        }
    }
};

namespace mix {
constexpr int SHM = 16384;
#define KSWZ(row, colB) ((row) * 256 + ((colB) ^ (((row) & 7) << 4)))
__device__ __forceinline__ int v_st(int k, int c) { const int kk = (k & ~0xC) | ((k & 4) << 1) | ((k & 8) >> 1); return ((kk >> 3) * 4 + (c >> 5)) * 512 + ((kk & 7) * 32 + (c & 31)) * 2; }
__device__ __forceinline__ int v_rd_base(int lane) { return ((lane & 3) << 3) | (((lane >> 2) & 3) << 6) | (((lane >> 4) & 1) << 5) | (((lane >> 5) & 1) << 8); }
__device__ __forceinline__ int crow(int r, int hi) { return (r & 3) + 8 * (r >> 2) + 4 * hi; }
__device__ __forceinline__ int pinv(int k) { return ((k & 8) << 1) | ((k & 4) << 1) | ((k & 16) >> 2) | (k & 3); }
#define TRRD(dst, base, off) dst = __builtin_amdgcn_ds_read_tr16_b64_v4i16((LAS s16x4*)((LAS unsigned char*)(uintptr_t)(unsigned)(base) + (off)))
#define PK4(P, B_, OUT) do { unsigned a0 = cvtpk(P[B_+0], P[B_+1]), a1 = cvtpk(P[B_+2], P[B_+3]);                          \
        unsigned b0 = cvtpk(P[B_+4], P[B_+5]), b1 = cvtpk(P[B_+6], P[B_+7]);                                             \
        auto r0 = __builtin_amdgcn_permlane32_swap(a0, b0, false, false); auto r1 = __builtin_amdgcn_permlane32_swap(a1, b1, false, false); \
        u32x4 w = {r0[0], r1[0], r0[1], r1[1]}; OUT = *reinterpret_cast<bf16x8*>(&w); } while (0)
__device__ __forceinline__ bf16x8 cat8(s16x4 l, s16x4 h) { return (bf16x8){l[0], l[1], l[2], l[3], h[0], h[1], h[2], h[3]}; }

template <int KB>
__device__ __forceinline__ void qkt(f32x16& p0, f32x16& p1, const char* K_lds, int r32, int hi, const bf16x8* qr) {
    p0 = f32x16{}; p1 = f32x16{};
    const char* kb[4];
#pragma unroll
    for (int dd = 0; dd < 4; ++dd) kb[dd] = K_lds + KB * SHM + KSWZ(r32, (dd * 16 + hi * 8) * 2);
#pragma unroll
    for (int d0 = 0; d0 < 8; ++d0) { const char* a = kb[d0 & 3] + (d0 >> 2) * 128;
        bf16x8 b0 = *reinterpret_cast<const bf16x8*>(a);
        bf16x8 b1 = *reinterpret_cast<const bf16x8*>(a + 32 * 256);
        p0 = __builtin_amdgcn_mfma_f32_32x32x16_bf16(b0, qr[d0], p0, 0, 0, 0);
        p1 = __builtin_amdgcn_mfma_f32_32x32x16_bf16(b1, qr[d0], p1, 0, 0, 0); }
}
template <int VB>
__device__ __forceinline__ void pv_tile(f32x16* o, int vb0, bf16x8 pa0, bf16x8 pa1, bf16x8 pa2, bf16x8 pa3) {
#define PV_D0(d0) do { s16x4 l0, l1, l2, l3, h0, h1, h2, h3; constexpr int b_ = VB * SHM + (d0) * 512; \
        TRRD(l0, vb0, b_); TRRD(h0, vb0, b_ + 2048); TRRD(l1, vb0, b_ + 4096); TRRD(h1, vb0, b_ + 6144); TRRD(l2, vb0, b_ + 8192); TRRD(h2, vb0, b_ + 10240); TRRD(l3, vb0, b_ + 12288); TRRD(h3, vb0, b_ + 14336); \
        \
        o[d0] = __builtin_amdgcn_mfma_f32_32x32x16_bf16(pa0, cat8(l0, h0), o[d0], 0, 0, 0);   \
        o[d0] = __builtin_amdgcn_mfma_f32_32x32x16_bf16(pa1, cat8(l1, h1), o[d0], 0, 0, 0);   \
        o[d0] = __builtin_amdgcn_mfma_f32_32x32x16_bf16(pa2, cat8(l2, h2), o[d0], 0, 0, 0);   \
        o[d0] = __builtin_amdgcn_mfma_f32_32x32x16_bf16(pa3, cat8(l3, h3), o[d0], 0, 0, 0); } while (0)
    PV_D0(0); PV_D0(1); PV_D0(2); PV_D0(3);
#undef PV_D0
}
__device__ __forceinline__ void sb_weights(f32x16& p0, f32x16& p1, float& Rrun, int hi) {
    float T1 = 1.f, T0 = 1.f;
#pragma unroll
    for (int r = 0; r < 16; ++r) { const float e = fast_exp2(fminf(p1[r], 80.f)); const float om = fast_rcp(1.0f + e); p1[r] = e * om; T1 *= om; }
#pragma unroll
    for (int r = 0; r < 16; ++r) { const float e = fast_exp2(fminf(p0[r], 80.f)); const float om = fast_rcp(1.0f + e); p0[r] = e * om; T0 *= om; }
    const auto s1 = __builtin_amdgcn_permlane32_swap(__float_as_uint(T1), __float_as_uint(T1), false, false);
    const auto s0 = __builtin_amdgcn_permlane32_swap(__float_as_uint(T0), __float_as_uint(T0), false, false);
    const float T1p = __uint_as_float(hi ? s1[0] : s1[1]), T0p = __uint_as_float(hi ? s0[0] : s0[1]);
    const float t11 = T1 * T1p;
    float run = hi ? Rrun : Rrun * T1p;
#pragma unroll
    for (int r = 15; r >= 0; --r) { const float w = p1[r] * run; run -= w; p1[r] = w; }
    run = Rrun * t11 * (hi ? 1.0f : T0p);
#pragma unroll
    for (int r = 15; r >= 0; --r) { const float w = p0[r] * run; run -= w; p0[r] = w; }
    Rrun = Rrun * t11 * (T0 * T0p);
}
__device__ __forceinline__ void store_o32(const f32x16* o, unsigned char* Ow, int ldo, int r32, int hi) {
    const unsigned lo = (unsigned)(4 * hi * ldo + r32);
#pragma unroll
    for (int r = 0; r < 16; ++r) { unsigned char* rowp = Ow + (size_t)((r & 3) + 8 * (r >> 2)) * ldo;
#pragma unroll
        for (int d0 = 0; d0 < 4; ++d0) { const float v = o[d0][r]; const float v1 = __shfl_xor(v, 1), v2 = __shfl_xor(v, 2), v3 = __shfl_xor(v, 3);
            if ((r32 & 3) == 0) *(GAS unsigned*)(rowp + lo + d0 * 32) = pk_fp8x4(v, v1, v2, v3); } }
}

__device__ __forceinline__ void sb_part1(f32x16& p0, float& T0) {
    float t = 1.f;
#pragma unroll
    for (int r = 0; r < 16; ++r) { const float e = fast_exp2(fminf(p0[r], 80.f)); const float om = fast_rcp(1.0f + e); p0[r] = e * om; t *= om; }
    T0 = t;
}
__device__ __forceinline__ void sb_part2(f32x16& p0, f32x16& p1, float T0, float& Rrun, int hi, bf16x8& pa0, bf16x8& pa1, bf16x8& pa2, bf16x8& pa3) {
    float T1 = 1.f;
#pragma unroll
    for (int r = 0; r < 16; ++r) { const float e = fast_exp2(fminf(p1[r], 80.f)); const float om = fast_rcp(1.0f + e); p1[r] = e * om; T1 *= om; }
    const auto s1 = __builtin_amdgcn_permlane32_swap(__float_as_uint(T1), __float_as_uint(T1), false, false);
    const auto s0 = __builtin_amdgcn_permlane32_swap(__float_as_uint(T0), __float_as_uint(T0), false, false);
    const float T1p = __uint_as_float(hi ? s1[0] : s1[1]), T0p = __uint_as_float(hi ? s0[0] : s0[1]);
    const float t11 = T1 * T1p;
    float run = hi ? Rrun : Rrun * T1p;
#pragma unroll
    for (int r = 15; r >= 0; --r) { const float w = p1[r] * run; run -= w; p1[r] = w; }
    run = Rrun * t11 * (hi ? 1.0f : T0p);
#pragma unroll
    for (int r = 15; r >= 0; --r) { const float w = p0[r] * run; run -= w; p0[r] = w; }
    Rrun = Rrun * t11 * (T0 * T0p);
    PK4(p0, 0, pa0); PK4(p0, 8, pa1); PK4(p1, 0, pa2); PK4(p1, 8, pa3);
}
__device__ __forceinline__ void qkt_rt(f32x16& p0, f32x16& p1, const LAS unsigned char* K_lds, int kbo, int r32, int hi, const bf16x8* qr) {
    p0 = f32x16{}; p1 = f32x16{};
    const LAS unsigned char* kb[4];
#pragma unroll
    for (int dd = 0; dd < 4; ++dd) kb[dd] = K_lds + kbo + KSWZ(r32, (dd * 16 + hi * 8) * 2);
#pragma unroll
    for (int d0 = 0; d0 < 8; ++d0) { const LAS unsigned char* a = kb[d0 & 3] + (d0 >> 2) * 128;
        bf16x8 b0 = *reinterpret_cast<const LAS bf16x8*>(a);
        bf16x8 b1 = *reinterpret_cast<const LAS bf16x8*>(a + 32 * 256);
        p0 = __builtin_amdgcn_mfma_f32_32x32x16_bf16(b0, qr[d0], p0, 0, 0, 0);
        p1 = __builtin_amdgcn_mfma_f32_32x32x16_bf16(b1, qr[d0], p1, 0, 0, 0); }
}
__device__ __forceinline__ void pv_rt(f32x16* o, int vb, bf16x8 pa0, bf16x8 pa1, bf16x8 pa2, bf16x8 pa3) {
#define PV_D0(d0) do { s16x4 l0, l1, l2, l3, h0, h1, h2, h3; constexpr int b_ = (d0) * 512; \
        TRRD(l0, vb, b_); TRRD(h0, vb, b_ + 2048); TRRD(l1, vb, b_ + 4096); TRRD(h1, vb, b_ + 6144); TRRD(l2, vb, b_ + 8192); TRRD(h2, vb, b_ + 10240); TRRD(l3, vb, b_ + 12288); TRRD(h3, vb, b_ + 14336); \
        \
        o[d0] = __builtin_amdgcn_mfma_f32_32x32x16_bf16(pa0, cat8(l0, h0), o[d0], 0, 0, 0);   \
        o[d0] = __builtin_amdgcn_mfma_f32_32x32x16_bf16(pa1, cat8(l1, h1), o[d0], 0, 0, 0);   \
        o[d0] = __builtin_amdgcn_mfma_f32_32x32x16_bf16(pa2, cat8(l2, h2), o[d0], 0, 0, 0);   \
        o[d0] = __builtin_amdgcn_mfma_f32_32x32x16_bf16(pa3, cat8(l3, h3), o[d0], 0, 0, 0); } while (0)
    PV_D0(0); PV_D0(1); SBAR(); PV_D0(2); PV_D0(3);
#undef PV_D0
}
__device__ __forceinline__ int key_of_row(int i) { const int j = i & 31; return (i & 32) + ((j >> 2) & 1) * 16 + ((j >> 3) & 3) * 4 + (j & 3); }
__device__ __forceinline__ void sb_all(f32x16& p0, f32x16& p1, float& Rrun, int hi, bf16x8& pa0, bf16x8& pa1, bf16x8& pa2, bf16x8& pa3) {
    float T1 = 1.f, T0 = 1.f;
#pragma unroll
    for (int r = 0; r < 16; ++r) { const float om = fast_rcp(1.0f + fast_exp2(p1[r])); p1[r] = 1.0f - om; T1 *= om; }
#pragma unroll
    for (int r = 0; r < 16; ++r) { const float om = fast_rcp(1.0f + fast_exp2(p0[r])); p0[r] = 1.0f - om; T0 *= om; }
    const auto s1 = __builtin_amdgcn_permlane32_swap(__float_as_uint(T1), __float_as_uint(T1), false, false);
    const auto s0 = __builtin_amdgcn_permlane32_swap(__float_as_uint(T0), __float_as_uint(T0), false, false);
    const float T1p = __uint_as_float(hi ? s1[0] : s1[1]), T0p = __uint_as_float(hi ? s0[0] : s0[1]);
    const float t11 = T1 * T1p;
    float run = hi ? Rrun : Rrun * T1p;
#pragma unroll
    for (int r = 15; r >= 0; --r) { const float w = p1[r] * run; run -= w; p1[r] = w; }
    run = Rrun * t11 * (hi ? 1.0f : T0p);
#pragma unroll
    for (int r = 15; r >= 0; --r) { const float w = p0[r] * run; run -= w; p0[r] = w; }
    Rrun = Rrun * t11 * (T0 * T0p);
    PK4(p0, 0, pa0); PK4(p0, 8, pa1); PK4(p1, 0, pa2); PK4(p1, 8, pa3);
}
__device__ __forceinline__ void attn_item(const bf16* U, bf16* O, int bh, int qb, LAS unsigned char* ldsl, char* lds, const int g_wv, const int pmode) {
    const int tid = TIDX, wid = g_wv, lane = tid & 63, r32 = lane & 31, hi = lane >> 5;
    const int b = bh >> 3, h = bh & 7;
    const bf16* Qp = U + (size_t)(b * SEQ + qb * 256) * INC + h * HD;
    const bf16* Kp = U + (size_t)(b * SEQ) * INC + 1024 + h * HD;
    const bf16* Vp = U + (size_t)(b * SEQ) * INC + 2048 + h * HD;
    const LAS unsigned char* K_lds = ldsl; char* V_lds = lds + 4 * SHM;
    bf16x8 qr[8];
    { const unsigned lo_q = (unsigned)((wid * 32 + r32) * INC + hi * 8);
#pragma unroll
      for (int d0 = 0; d0 < 8; ++d0) qr[d0] = *(const GAS bf16x8*)(Qp + lo_q + d0 * 16); }
    unsigned ksrc[2], vsrc[2];
#pragma unroll
    for (int i = 0; i < 2; ++i) { const int p = 2 * wid + i;
        { const int row = 4 * p + (lane >> 4), ch = (lane & 15) ^ (row & 7); ksrc[i] = (unsigned)(key_of_row(row) * INC + ch * 8); }
        { const int S = 2 * p + (lane >> 5), kk = (S >> 2) * 8 + ((lane & 31) >> 2), c = (S & 3) * 32 + (lane & 3) * 8; const int k = (kk & ~0xC) | ((kk & 4) << 1) | ((kk & 8) >> 1);
          vsrc[i] = (unsigned)(key_of_row(k) * INC + c); } }
    const int vb0 = (int)(uintptr_t)V_lds + v_rd_base(lane);
    const LAS unsigned char* kbase[4];
#pragma unroll
    for (int dd = 0; dd < 4; ++dd) kbase[dd] = K_lds + KSWZ(r32, (dd * 16 + hi * 8) * 2);
    const int NT = 4 * (qb + 1);
    const int qlo = qb * 256 + wid * 32;
    volatile LAS unsigned* eflag = (volatile LAS unsigned*)(ldsl + LDSCTL_OFF) + 32;
    const float RTH = 8.27e-25f;
#define DMA_TILE(t_) do { const size_t ro_ = (size_t)((pmode == 1 ? 0 : (NT - 1 - (t_))) * 64) * INC; const int so_ = ((t_) & 3) * SHM + wid * 2048; \
        _Pragma("unroll") for (int i_ = 0; i_ < 2; ++i_) { \
            __builtin_amdgcn_global_load_lds((const unsigned*)(Kp + ro_ + ksrc[i_]), (LAS unsigned*)(ldsl + so_ + i_ * 1024), 16, 0, 0); \
            __builtin_amdgcn_global_load_lds((const unsigned*)(Vp + ro_ + vsrc[i_]), (LAS unsigned*)(ldsl + 4 * SHM + so_ + i_ * 1024), 16, 0, 0); } } while (0)
#define SBMASK(P0_, P1_, t_) do { const int kb_ = (NT - 1 - (t_)) * 64; if (kb_ + 63 >= qlo) { const int dq = qlo + r32 - kb_ - 16 * hi; const float NEG = -__builtin_inff(); \
        _Pragma("unroll") for (int r = 0; r < 16; ++r) { if (r >= dq) P0_[r] = NEG; if (r + 32 >= dq) P1_[r] = NEG; } } } while (0)
#define WAITV(n_) asm volatile("s_waitcnt vmcnt(" #n_ ")" ::: "memory")
#define RBAR() do { asm volatile("s_waitcnt lgkmcnt(0)" ::: "memory"); __builtin_amdgcn_s_barrier(); asm volatile("" ::: "memory"); } while (0)
#define QK2(PX0, PX1, ko_, s_) do { const LAS unsigned char* a_ = kbase[(s_) & 3] + (ko_) + ((s_) >> 2) * 128; \
        const bf16x8 b0_ = *reinterpret_cast<const LAS bf16x8*>(a_), b1_ = *reinterpret_cast<const LAS bf16x8*>(a_ + 32 * 256); \
        PX0 = __builtin_amdgcn_mfma_f32_32x32x16_bf16(b0_, qr[s_], PX0, 0, 0, 0); PX1 = __builtin_amdgcn_mfma_f32_32x32x16_bf16(b1_, qr[s_], PX1, 0, 0, 0); } while (0)
#define EB(P_, r_, T_) do { const float om_ = fast_rcp(1.0f + fast_exp2(P_[r_])); P_[r_] = 1.0f - om_; T_ *= om_; } while (0)
#define WB(P_, r_) do { float w_; asm("v_mul_f32 %0, %1, %2" : "=v"(w_) : "v"(P_[r_]), "v"(run)); asm("v_sub_f32 %0, %1, %2" : "=v"(run) : "v"(run), "v"(w_)); P_[r_] = w_; } while (0)
#define BLOCK1(PX0, PX1, PY0, PY1, T0Y, ko_) do { PX0 = f32x16{}; PX1 = f32x16{}; float T1 = 1.f, run, T1p, T0p, t11; \
        QK2(PX0, PX1, ko_, 0); EB(PY1, 0, T1); EB(PY1, 1, T1); EB(PY1, 2, T1); EB(PY1, 3, T1); EB(PY1, 4, T1); EB(PY1, 5, T1); SBAR(); \
        QK2(PX0, PX1, ko_, 1); EB(PY1, 6, T1); EB(PY1, 7, T1); EB(PY1, 8, T1); EB(PY1, 9, T1); EB(PY1, 10, T1); SBAR(); \
        QK2(PX0, PX1, ko_, 2); EB(PY1, 11, T1); EB(PY1, 12, T1); EB(PY1, 13, T1); EB(PY1, 14, T1); EB(PY1, 15, T1); \
        { const auto s1_ = __builtin_amdgcn_permlane32_swap(__float_as_uint(T1), __float_as_uint(T1), false, false); const auto s0_ = __builtin_amdgcn_permlane32_swap(__float_as_uint(T0Y), __float_as_uint(T0Y), false, false); \
          T1p = __uint_as_float(hi ? s1_[0] : s1_[1]); T0p = __uint_as_float(hi ? s0_[0] : s0_[1]); t11 = T1 * T1p; run = hi ? Rrun : Rrun * T1p; } SBAR(); \
        QK2(PX0, PX1, ko_, 3); WB(PY1, 15); WB(PY1, 14); WB(PY1, 13); WB(PY1, 12); WB(PY1, 11); WB(PY1, 10); WB(PY1, 9); WB(PY1, 8); SBAR(); \
        QK2(PX0, PX1, ko_, 4); WB(PY1, 7); WB(PY1, 6); WB(PY1, 5); WB(PY1, 4); WB(PY1, 3); WB(PY1, 2); WB(PY1, 1); WB(PY1, 0); run = Rrun * t11 * (hi ? 1.0f : T0p); SBAR(); \
        QK2(PX0, PX1, ko_, 5); WB(PY0, 15); WB(PY0, 14); WB(PY0, 13); WB(PY0, 12); WB(PY0, 11); WB(PY0, 10); WB(PY0, 9); WB(PY0, 8); SBAR(); \
        QK2(PX0, PX1, ko_, 6); WB(PY0, 7); WB(PY0, 6); WB(PY0, 5); WB(PY0, 4); WB(PY0, 3); WB(PY0, 2); WB(PY0, 1); WB(PY0, 0); Rrun = Rrun * t11 * (T0Y * T0p); SBAR(); \
        QK2(PX0, PX1, ko_, 7); PK4(PY0, 0, pa0); PK4(PY0, 8, pa1); PK4(PY1, 0, pa2); PK4(PY1, 8, pa3); SBAR(); } while (0)
#define PART1(P0_, T0_) do { float t_ = 1.f; _Pragma("unroll") for (int r = 0; r < 16; ++r) EB(P0_, r, t_); T0_ = t_; } while (0)
    DMA_TILE(0); DMA_TILE(1);
    WAITV(4); RBAR();
    float Rrun = 1.f, T0A, T0B; f32x16 o[4] = {};
    f32x16 pA0, pA1, pB0, pB1; bf16x8 pa0, pa1, pa2, pa3;
    DMA_TILE(2);
    qkt_rt(pA0, pA1, K_lds, 0, r32, hi, qr);
    SBMASK(pA0, pA1, 0); PART1(pA0, T0A);
    WAITV(4); RBAR();
#define STEP(PX0, PX1, T0X, PY0, PY1, T0Y, t_) do { \
        if ((t_) + 2 < NT) DMA_TILE((t_) + 2); SBAR(); \
        BLOCK1(PX0, PX1, PY0, PY1, T0Y, ((t_) & 3) * SHM); \
        { const bool wd_ = __all(Rrun < RTH); if (lane == 0) eflag[((t_) & 1) * 8 + wid] = wd_ ? 1u : 0u; } \
        pv_rt(o, vb0 + (((t_) - 1) & 3) * SHM, pa0, pa1, pa2, pa3); \
        SBMASK(PX0, PX1, t_); PART1(PX0, T0X); SBAR(); \
        if ((t_) + 2 < NT) WAITV(4); else WAITV(0); \
        RBAR(); \
        { unsigned s_ = 0u; _Pragma("unroll") for (int w_ = 0; w_ < 8; ++w_) s_ += eflag[((t_) & 1) * 8 + w_]; done = ((unsigned)__builtin_amdgcn_readfirstlane((int)s_) == 8u) && (pmode == 0); } } while (0)
    int t = 1, NTe = NT; bool done = false;
    for (; t + 1 < NTe; t += 2) { STEP(pB0, pB1, T0B, pA0, pA1, T0A, t); STEP(pA0, pA1, T0A, pB0, pB1, T0B, t + 1); NTe = done ? 0 : NTe; }
    STEP(pB0, pB1, T0B, pA0, pA1, T0A, t);
    sb_part2(pB0, pB1, T0B, Rrun, hi, pa0, pa1, pa2, pa3); SBAR();
    pv_rt(o, vb0 + (t & 3) * SHM, pa0, pa1, pa2, pa3);
    asm volatile("s_waitcnt vmcnt(0)" ::: "memory");
#undef STEP
#undef BLOCK1
#undef PART1
#undef QK2
#undef EB
#undef WB
#undef DMA_TILE
#undef SBMASK
#undef WAITV
#undef RBAR
    store_o32(o, (unsigned char*)O + (size_t)(b * SEQ + qb * 256 + wid * 32) * D + h * HD, D, r32, hi);
}

__device__ __forceinline__ void ret_state_stream(const bf16* U, bf16* RTg, int bh, char* lds, const int g_wv) {
    const int tid = TIDX, wid = g_wv, lane = tid & 63, r32 = lane & 31, hi = lane >> 5;
    const int dkb = wid & 3, dvh = wid >> 2;
    const int b = bh >> 3, h = bh & 7;
    const float lg = __log2f(1.0f - __builtin_ldexpf(1.0f, -5 - h));
    const bf16* Kp = U + (size_t)(b * SEQ) * INC + 4096 + h * HD;
    const bf16* Vp = U + (size_t)(b * SEQ) * INC + 5120 + h * HD;
    const int sr = tid >> 4, sc = (tid & 15) * 8;
    const unsigned lo_kv = (unsigned)(sr * INC + sc);
    const int ktb0 = (int)(uintptr_t)lds + v_rd_base(lane) + dkb * 512, vtb0 = (int)(uintptr_t)(lds + 32768) + v_rd_base(lane) + dvh * 1024;
    const int ktb1 = ktb0 + 65536, vtb1 = vtb0 + 65536;
    bf16x8 ka[4], va[4], kb[4], vb[4];
    const float cd = fast_exp2(128.0f * lg);
    f32x16 Racc[2] = {};
#define SLOADS(n_, K_, V_) do { _Pragma("unroll") for (int i = 0; i < 4; ++i) { const size_t ro = (size_t)((n_) * 128 + 32 * i) * INC; const bf16* kp_ = Kp + ro + lo_kv; const bf16* vp_ = Vp + ro + lo_kv; \
        asm volatile("global_load_dwordx4 %0, %1, off" : "=&v"(K_[i]) : "v"(kp_) : "memory"); asm volatile("global_load_dwordx4 %0, %1, off" : "=&v"(V_[i]) : "v"(vp_) : "memory"); } } while (0)
#define SWAIT(cnt_first, K_, V_) do { if (n == 0) asm volatile("s_waitcnt vmcnt(" #cnt_first ")" ::: "memory"); else if (n >= 28) asm volatile("s_waitcnt vmcnt(0)" ::: "memory"); else asm volatile("s_waitcnt vmcnt(24)" ::: "memory"); \
        asm volatile("" : "+v"(K_[0]), "+v"(K_[1]), "+v"(K_[2]), "+v"(K_[3]), "+v"(V_[0]), "+v"(V_[1]), "+v"(V_[2]), "+v"(V_[3])); } while (0)
#define SWRITES(p_, K_, V_) do { float lgw = lg; asm volatile("" : "+v"(lgw)); _Pragma("unroll") for (int i = 0; i < 4; ++i) { const int c = sr + 32 * i, tile = i >> 1, cr = c & 63; \
        const float f = fast_exp2((float)(127 - c) * lgw); const u32x4 kw = *reinterpret_cast<const u32x4*>(&K_[i]); u32x4 kd; \
        kd.x = cvtpk(bflo(kw.x) * f, bfhi(kw.x) * f); kd.y = cvtpk(bflo(kw.y) * f, bfhi(kw.y) * f); kd.z = cvtpk(bflo(kw.z) * f, bfhi(kw.z) * f); kd.w = cvtpk(bflo(kw.w) * f, bfhi(kw.w) * f); \
        *(u32x4*)(lds + (p_) * 65536 + tile * SHM + v_st(cr, sc)) = kd; \
        *(bf16x8*)(lds + (p_) * 65536 + 32768 + tile * SHM + v_st(cr, sc)) = V_[i]; } } while (0)
#define SCOMPUTE(KTB, VTB) do { _Pragma("unroll") for (int r = 0; r < 16; ++r) { Racc[0][r] *= cd; Racc[1][r] *= cd; } \
        _Pragma("unroll") for (int tl = 0; tl < 2; ++tl) _Pragma("unroll") for (int ks = 0; ks < 4; ++ks) { s16x4 al, ah, bl0, bh0, bl1, bh1; const int o_ = tl * SHM + ks * 4096; \
            TRRD(al, KTB, o_); TRRD(ah, KTB, o_ + 2048); TRRD(bl0, VTB, o_); TRRD(bh0, VTB, o_ + 2048); TRRD(bl1, VTB, o_ + 512); TRRD(bh1, VTB, o_ + 512 + 2048); \
            const bf16x8 af = cat8(al, ah); \
            Racc[0] = __builtin_amdgcn_mfma_f32_32x32x16_bf16(af, cat8(bl0, bh0), Racc[0], 0, 0, 0); \
            Racc[1] = __builtin_amdgcn_mfma_f32_32x32x16_bf16(af, cat8(bl1, bh1), Racc[1], 0, 0, 0); } } while (0)
#define SSTORE(n1_) do { bf16* rt = RTg + (size_t)(bh * 32 + (n1_)) * 16384; _Pragma("unroll") for (int t = 0; t < 2; ++t) _Pragma("unroll") for (int g = 0; g < 4; ++g) { \
        u32x2 w; w.x = cvtpk(Racc[t][4 * g], Racc[t][4 * g + 1]); w.y = cvtpk(Racc[t][4 * g + 2], Racc[t][4 * g + 3]); \
        *(GAS u32x2*)(rt + (size_t)((2 * dvh + t) * 32 + r32) * 128 + dkb * 32 + 8 * g + 4 * hi) = w; } } while (0)
    SLOADS(0, ka, va); SLOADS(1, kb, vb);
    for (int n = 0; n < 31; n += 2) {
        SWAIT(8, ka, va); SWRITES(0, ka, va); SBAR();
        if (n + 2 < 31) SLOADS(n + 2, ka, va);
        __syncthreads();
        SCOMPUTE(ktb0, vtb0); SSTORE(n + 1);
        if (n + 1 < 31) {
            SWAIT(16, kb, vb); SWRITES(1, kb, vb); SBAR();
            if (n + 3 < 31) SLOADS(n + 3, kb, vb);
            __syncthreads();
            SCOMPUTE(ktb1, vtb1); SSTORE(n + 2);
        }
    }
    asm volatile("s_waitcnt vmcnt(0)" ::: "memory");
    __syncthreads();
#undef SLOADS
#undef SWAIT
#undef SWRITES
#undef SCOMPUTE
#undef SSTORE
}

__device__ __forceinline__ float row16_sum(float s) {
    s += __builtin_bit_cast(float, __builtin_amdgcn_update_dpp(0, __builtin_bit_cast(int, s), 0xB1, 0xf, 0xf, false));
    s += __builtin_bit_cast(float, __builtin_amdgcn_update_dpp(0, __builtin_bit_cast(int, s), 0x4E, 0xf, 0xf, false));
    s += __builtin_bit_cast(float, __builtin_amdgcn_update_dpp(0, __builtin_bit_cast(int, s), 0x124, 0xf, 0xf, false));
    s += __builtin_bit_cast(float, __builtin_amdgcn_update_dpp(0, __builtin_bit_cast(int, s), 0x128, 0xf, 0xf, false));
    return s;
}
__device__ __forceinline__ void ret_chunk_items(const bf16* U, const bf16* RTg, bf16* O, const float* gn_g, char* lds, const int g_wv) {
    const int tid = TIDX, wid = g_wv, lane = tid & 63, r32 = lane & 31, hi = lane >> 5;
    const int ib = wid & 3, dvh = wid >> 2;
    char* KS = lds; char* VT = lds + 32768; char* GT = lds + 65536; char* RT = lds + 98304; float* SSQ = (float*)(lds + 131072);
    const int sr = tid >> 4, sc = (tid & 15) * 8;
    const unsigned lo_kv = (unsigned)(sr * INC + sc), lo_q = (unsigned)((ib * 32 + r32) * INC + hi * 8), lo_r = (unsigned)(sr * 128 + sc);
    const int vtb = (int)(uintptr_t)VT + v_rd_base(lane) + dvh * 1024;
    const char* ksb[4];
#pragma unroll
    for (int dd = 0; dd < 4; ++dd) ksb[dd] = KS + KSWZ(r32, (dd * 16 + hi * 8) * 2);
    const char* rtb[4];
#pragma unroll
    for (int dd = 0; dd < 4; ++dd) rtb[dd] = RT + KSWZ(dvh * 64 + r32, (dd * 16 + hi * 8) * 2);
    bf16x8 sk[4], sv[4], sg[4], srr[4], qr[8];
    const int G = (int)gridDim.x;
#define RC_BASE(it_) const int bh_ = (it_) & 31, n_ = (it_) >> 5, b_ = bh_ >> 3, h_ = bh_ & 7; const size_t rowbase_ = (size_t)(b_ * SEQ + n_ * 128)
#define RC_LOAD_KVG(it_) do { RC_BASE(it_); const bf16* Kp = U + rowbase_ * INC + 4096 + h_ * HD; const bf16* Vp = U + rowbase_ * INC + 5120 + h_ * HD; \
        _Pragma("unroll") for (int i = 0; i < 4; ++i) { const size_t ro = (size_t)(32 * i) * INC; sk[i] = *(const GAS bf16x8*)(Kp + ro + lo_kv); sv[i] = *(const GAS bf16x8*)(Vp + ro + lo_kv); } } while (0)
#define RC_LOAD_QR(it_) do { RC_BASE(it_); const bf16* Qp = U + rowbase_ * INC + 3072 + h_ * HD; const bf16* Gp = U + rowbase_ * INC + 6144 + h_ * HD; \
        _Pragma("unroll") for (int i = 0; i < 4; ++i) sg[i] = *(const GAS bf16x8*)(Gp + (size_t)(32 * i) * INC + lo_kv); \
        _Pragma("unroll") for (int d0 = 0; d0 < 8; ++d0) qr[d0] = *(const GAS bf16x8*)(Qp + lo_q + d0 * 16); \
        if (n_ > 0) { const bf16* rt = RTg + (size_t)(bh_ * 32 + n_) * 16384; \
            _Pragma("unroll") for (int i = 0; i < 4; ++i) srr[i] = *(const GAS bf16x8*)(rt + (size_t)(32 * i) * 128 + lo_r); } } while (0)
    int it = (int)blockIdx.x;
    if (it >= 1024) return;
    RC_LOAD_KVG(it); RC_LOAD_QR(it);
    for (; it < 1024; it += G) {
        RC_BASE(it);
        const float lg = __log2f(1.0f - __builtin_ldexpf(1.0f, -5 - h_));
#pragma unroll
        for (int i = 0; i < 4; ++i) { const int c = sr + 32 * i, tile = i >> 1, cr = c & 63;
            const float fs = fast_exp2(-(float)c * lg); const u32x4 kw = *reinterpret_cast<const u32x4*>(&sk[i]); u32x4 ke;
            ke.x = cvtpk(bflo(kw.x) * fs, bfhi(kw.x) * fs); ke.y = cvtpk(bflo(kw.y) * fs, bfhi(kw.y) * fs); ke.z = cvtpk(bflo(kw.z) * fs, bfhi(kw.z) * fs); ke.w = cvtpk(bflo(kw.w) * fs, bfhi(kw.w) * fs);
            *(u32x4*)(KS + tile * SHM + KSWZ(cr, sc * 2)) = ke;
            *(bf16x8*)(VT + tile * SHM + v_st(cr, sc)) = sv[i];
            *(bf16x8*)(GT + c * 256 + sc * 2) = sg[i];
            if (n_ > 0) *(bf16x8*)(RT + KSWZ(c, sc * 2)) = srr[i]; }
        SBAR();
        if (it + G < 1024) RC_LOAD_KVG(it + G);
        const float lf = fast_exp2((float)(ib * 32 + r32) * lg);
        __syncthreads();
        f32x16 acc[2] = {};
        if (n_ > 0) {
#pragma unroll
            for (int t = 0; t < 2; ++t)
#pragma unroll
                for (int s = 0; s < 8; ++s) { const bf16x8 rfr = *(const bf16x8*)(rtb[s & 3] + t * 8192 + (s >> 2) * 128); acc[t] = __builtin_amdgcn_mfma_f32_32x32x16_bf16(qr[s], rfr, acc[t], 0, 0, 0); }
#pragma unroll
            for (int r = 0; r < 16; ++r) { const float f = fast_exp2((float)(ib * 32 + crow(r, hi) + 1) * lg); acc[0][r] *= f; acc[1][r] *= f; }
        }
#pragma unroll
        for (int jb = 0; jb < 4; ++jb) {
            if (jb <= ib) {
                f32x16 p = {};
#pragma unroll
                for (int d0 = 0; d0 < 8; ++d0) { const bf16x8 kf = *(const bf16x8*)(ksb[d0 & 3] + (jb >> 1) * SHM + (jb & 1) * 8192 + (d0 >> 2) * 128);
                    p = __builtin_amdgcn_mfma_f32_32x32x16_bf16(kf, qr[d0], p, 0, 0, 0); }
#pragma unroll
                for (int r = 0; r < 16; ++r) { const int diff = (ib - jb) * 32 + r32 - crow(r, hi); p[r] = diff >= 0 ? p[r] * lf : 0.f; }
                bf16x8 pa0, pa1; PK4(p, 0, pa0); PK4(p, 8, pa1); SBAR();
#pragma unroll
                for (int t = 0; t < 2; ++t) { s16x4 l0, h0, l1, h1; const int o_ = (jb >> 1) * SHM + t * 512 + (jb & 1) * 8192;
                    TRRD(l0, vtb, o_); TRRD(h0, vtb, o_ + 2048); TRRD(l1, vtb, o_ + 4096); TRRD(h1, vtb, o_ + 6144);
                    acc[t] = __builtin_amdgcn_mfma_f32_32x32x16_bf16(pa0, cat8(l0, h0), acc[t], 0, 0, 0);
                    acc[t] = __builtin_amdgcn_mfma_f32_32x32x16_bf16(pa1, cat8(l1, h1), acc[t], 0, 0, 0); }
            }
        }
        SBAR();
        if (it + G < 1024) RC_LOAD_QR(it + G);
        float* ssqw = SSQ + wid * 32 + 4 * hi; const float* ssqp = SSQ + (wid ^ 4) * 32 + 4 * hi;
#pragma unroll
        for (int r = 0; r < 16; ++r) { float s = row16_sum(acc[0][r] * acc[0][r] + acc[1][r] * acc[1][r]); s += __shfl_xor(s, 16);
            if (r32 == 0) ssqw[(r & 3) + 8 * (r >> 2)] = s; }
        __syncthreads();
        {
            const float gn0 = gn_g[h_ * HD + dvh * 64 + r32], gn1 = gn_g[h_ * HD + dvh * 64 + 32 + r32];
            const char* gtp = GT + (ib * 32 + 4 * hi) * 256 + (dvh * 64 + r32) * 2; char* otp = KS + (ib * 32 + 4 * hi) * 256 + (dvh * 64 + r32) * 2;
#pragma unroll
            for (int r = 0; r < 16; ++r) { const int cr = (r & 3) + 8 * (r >> 2);
                const float rstd = __builtin_amdgcn_rsqf((ssqw[cr] + ssqp[cr]) * (1.0f / HD) + EPS);
                const float g0 = bf2f(*(const unsigned short*)(gtp + cr * 256)), g1 = bf2f(*(const unsigned short*)(gtp + cr * 256 + 64));
                const float v0 = acc[0][r] * rstd * gn0 * silu_f(g0), v1 = acc[1][r] * rstd * gn1 * silu_f(g1);
                *(unsigned short*)(otp + cr * 256) = (unsigned short)(cvtpk(v0, 0.f) & 0xffffu); *(unsigned short*)(otp + cr * 256 + 64) = (unsigned short)(cvtpk(v1, 0.f) & 0xffffu); }
        }
        __syncthreads();
        {
            unsigned char* Ow = (unsigned char*)O + rowbase_ * D + 1024 + h_ * HD;
#pragma unroll
            for (int i = 0; i < 4; ++i) { const int c = sr + 32 * i; const u32x4 w = *(const u32x4*)(KS + c * 256 + sc * 2); u32x2 o8;
                o8.x = pk_fp8x4(bflo(w.x), bfhi(w.x), bflo(w.y), bfhi(w.y)); o8.y = pk_fp8x4(bflo(w.z), bfhi(w.z), bflo(w.w), bfhi(w.w));
                *(GAS u32x2*)(Ow + (size_t)c * D + sc) = o8; }
        }
        __syncthreads();
    }
#undef RC_BASE
#undef RC_LOAD_KVG
#undef RC_LOAD_QR
}

__device__ __forceinline__ void p3_mixer(const Args& a, LAS unsigned char* ldsl, char* lds, const int g_wv, const int qoff, const int do_ret, const int pmode) {
    const bf16* U = (const bf16*)(a.ws + WS_U); bf16* O = (bf16*)(a.ws + WS_H1);
    unsigned* qhead = (unsigned*)(a.ws + WS_CTL) + CW_QHEAD + qoff;
    LAS unsigned* slot = (LAS unsigned*)(ldsl + LDSCTL_OFF) + 16;
    if ((do_ret & 1) && (int)blockIdx.x < 32) ret_state_stream(U, (bf16*)(a.ws + WS_ACT), (int)blockIdx.x, lds, g_wv);
    if (do_ret & 2) return;
    const int grp = (int)(blockIdx.x & 7);
    for (;;) {
        __syncthreads();
        if (TIDX == 0) *slot = __hip_atomic_fetch_add(qhead + 64 * grp + 64, 1u, __ATOMIC_RELAXED, __HIP_MEMORY_SCOPE_AGENT);
        __syncthreads();
        const unsigned it = *slot;
        if (it >= 64u) break;
        attn_item(U, pmode ? (bf16*)(a.ws + WS_ACT + 64 * MiB) : O, grp + 8 * (int)(it & 3u), 15 - (int)(it >> 2), ldsl, lds, g_wv, pmode);
    }
    if (qoff == 0 && pmode == 0) {
        unsigned* cq = (unsigned*)(a.ws + WS_CTL) + CW_CVQ;
        for (;;) {
            __syncthreads();
            if (TIDX == 0) *slot = __hip_atomic_fetch_add(cq, 1u, __ATOMIC_RELAXED, __HIP_MEMORY_SCOPE_AGENT);
            __syncthreads();
            const int clo = CV_SPLIT + (int)(*slot) * 64;
            if (clo >= CV_NIT) break;
            cvt_run<true>(a.ws, ldsl, g_wv, clo, (clo + 64 < CV_NIT) ? clo + 64 : CV_NIT, 1);
        }
    }
}
__device__ __forceinline__ void p3_ret_chunks(const Args& a, char* lds, const int g_wv) {
    const bf16* U = (const bf16*)(a.ws + WS_U); bf16* O = (bf16*)(a.ws + WS_H1);
    ret_chunk_items(U, (const bf16*)(a.ws + WS_ACT), O, a.in[I_RGN], lds, g_wv);
}
}

__device__ __forceinline__ void p5_router(const Args& a, LAS unsigned char* lds, const int g_wv, const int cbank, const int pm) {
    const int tid = TIDX, lane = tid & 63, wave = g_wv, G = gridDim.x, bx = blockIdx.x;
    const float* X1 = a.out; const float* modv = (const float*)(a.ws + WS_MOD); unsigned char* H2 = a.ws + WS_U;
    const float* Wr = a.in[I_WR]; const float rbias = a.in[I_RB][lane];
    unsigned* counts = (unsigned*)(a.ws + WS_CTL) + CW_CNT + cbank;
    int* LTOK = (int*)(a.ws + WS_LTOK); float* LW = (float*)(a.ws + WS_LW); unsigned* META = (unsigned*)(a.ws + WS_META);
    LAS float* h2f = (LAS float*)lds;
    constexpr int H2S = D + 8;
    LAS unsigned* lcnt = (LAS unsigned*)(lds + 16 * H2S * 4);
    LAS unsigned* lbase = lcnt + 64;
    LAS unsigned* rrec = lcnt + 128;
    LAS float* rgw = (LAS float*)(rrec + 1024);
    if (tid < 64) lcnt[tid] = 0u;
    __syncthreads();
    int ltile = 0;
    const bf16* Wrh = (const bf16*)(a.ws + WS_WR); const bf16* Wrl = Wrh + NE * D;
    f32x4 A[8], B[8]; int curb = -1;
    f32x4 vn[2][8];
    const int t0 = (int)((long)bx * (T / 16) / G), t1 = (int)((long)(bx + 1) * (T / 16) / G);
    if (t0 < t1) {
#pragma unroll
        for (int rr = 0; rr < 2; ++rr) { const GAS f32x4* xr = (const GAS f32x4*)(X1 + (size_t)(t0 * 16 + 2 * wave + rr) * D) + lane;
#pragma unroll
            for (int j = 0; j < 8; ++j) vn[rr][j] = xr[64 * j]; } }
    for (int tile = t0; tile < t1; ++tile) {
        const int row0 = tile * 16, b = row0 >> 12;
        if (b != curb) { curb = b;
#pragma unroll
            for (int j = 0; j < 8; ++j) { const int d = 4 * lane + 256 * j; const f32x4 g = *(const GAS f32x4*)(a.in[I_N2G] + d), sc = *(const GAS f32x4*)(modv + b * 16384 + 8192 + d);
                A[j] = g * (1.0f + sc); B[j] = *(const GAS f32x4*)(modv + b * 16384 + 6144 + d); } }
#pragma unroll
        for (int rr = 0; rr < 2; ++rr) { const int lr = 2 * wave + rr, row = row0 + lr;
            f32x4 v[8]; float ss = 0.f;
#pragma unroll
            for (int j = 0; j < 8; ++j) { v[j] = vn[rr][j]; ss += (v[j].x * v[j].x + v[j].y * v[j].y) + (v[j].z * v[j].z + v[j].w * v[j].w); }
            const float rstd = __builtin_amdgcn_rsqf(wave_sum(ss) * (1.0f / D) + EPS);
#pragma unroll
            for (int j = 0; j < 8; ++j) { const f32x4 h = v[j] * rstd * A[j] + B[j];
                *(LAS f32x4*)(h2f + lr * H2S + 4 * lane + 256 * j) = h; } }
        __syncthreads();
        f32x4 acc[4];
#pragma unroll
        for (int nt = 0; nt < 4; ++nt) acc[nt] = (f32x4){0.f, 0.f, 0.f, 0.f};
        if (pm != 1) {
            const int mrow = lane & 15, kq = lane >> 4;
            const LAS float* ap = h2f + mrow * H2S + 256 * wave + 8 * kq;
            const bf16* bph = Wrh + ((size_t)(wave * 8) * 256 + lane) * 8; const bf16* bpl = Wrl + ((size_t)(wave * 8) * 256 + lane) * 8;
#pragma unroll 2
            for (int ks = 0; ks < 8; ++ks) {
                bf16x8 bh[4], bl[4];
#pragma unroll
                for (int nt = 0; nt < 4; ++nt) { bh[nt] = *(const GAS bf16x8*)(bph + (size_t)(ks * 4 + nt) * 512); bl[nt] = *(const GAS bf16x8*)(bpl + (size_t)(ks * 4 + nt) * 512); }
                const f32x4 x0 = *(const LAS f32x4*)(ap + 32 * ks), x1 = *(const LAS f32x4*)(ap + 32 * ks + 4);
                u32x4 hw, lw;
                hw.x = cvtpk(x0.x, x0.y); hw.y = cvtpk(x0.z, x0.w); hw.z = cvtpk(x1.x, x1.y); hw.w = cvtpk(x1.z, x1.w);
                lw.x = cvtpk(x0.x - bflo(hw.x), x0.y - bfhi(hw.x)); lw.y = cvtpk(x0.z - bflo(hw.y), x0.w - bfhi(hw.y)); lw.z = cvtpk(x1.x - bflo(hw.z), x1.y - bfhi(hw.z)); lw.w = cvtpk(x1.z - bflo(hw.w), x1.w - bfhi(hw.w));
                const bf16x8 ah = *reinterpret_cast<const bf16x8*>(&hw), al = *reinterpret_cast<const bf16x8*>(&lw);
#pragma unroll
                for (int nt = 0; nt < 4; ++nt) {
                    acc[nt] = __builtin_amdgcn_mfma_f32_16x16x32_bf16(ah, bh[nt], acc[nt], 0, 0, 0);
                    acc[nt] = __builtin_amdgcn_mfma_f32_16x16x32_bf16(al, bh[nt], acc[nt], 0, 0, 0);
                    acc[nt] = __builtin_amdgcn_mfma_f32_16x16x32_bf16(ah, bl[nt], acc[nt], 0, 0, 0); }
            }
        }
#pragma unroll
        for (int rr = 0; rr < 2; ++rr) { const int lr = 2 * wave + rr; GAS unsigned* o8 = (GAS unsigned*)(H2 + (size_t)(row0 + lr) * D) + lane;
#pragma unroll
            for (int j = 0; j < 8; ++j) { const f32x4 h = *(const LAS f32x4*)(h2f + lr * H2S + 4 * lane + 256 * j); o8[64 * j] = pk_fp8x4(h.x, h.y, h.z, h.w); } }
        if (tile + 1 < t1) {
#pragma unroll
            for (int rr = 0; rr < 2; ++rr) { const GAS f32x4* xr = (const GAS f32x4*)(X1 + (size_t)((tile + 1) * 16 + 2 * wave + rr) * D) + lane;
#pragma unroll
                for (int j = 0; j < 8; ++j) vn[rr][j] = xr[64 * j]; } }
        __syncthreads();
        { const int col = lane & 15, rq = lane >> 4;
#pragma unroll
            for (int nt = 0; nt < 4; ++nt)
#pragma unroll
                for (int i = 0; i < 4; ++i) h2f[(wave * 16 + rq * 4 + i) * 64 + nt * 16 + col] = acc[nt][i]; }
        __syncthreads();
        if (pm == 0 || pm == 3) {
            bool sel2[2]; float gw2[2]; int jj2[2];
#pragma unroll
            for (int rr = 0; rr < 2; ++rr) { const int lr = 2 * wave + rr;
                float logit = 0.f;
#pragma unroll
                for (int w = 0; w < 8; ++w) logit += h2f[(w * 16 + lr) * 64 + lane];
                const float s = fast_rcp(1.0f + fast_exp2(-logit * LOG2E));
                const float ch = s + rbias;
                float m1 = ch; m1 = fmaxf(m1, __shfl_xor(m1, 1)); m1 = fmaxf(m1, __shfl_xor(m1, 2)); m1 = fmaxf(m1, __shfl_xor(m1, 4));
                const unsigned long long bal = __ballot(ch == m1);
                const int g = lane >> 3; const unsigned gb = (unsigned)(bal >> (8 * g)) & 0xffu; const int first = __builtin_ctz(gb | 0x100u);
                float m2 = ((lane & 7) == first) ? -__builtin_inff() : ch; m2 = fmaxf(m2, __shfl_xor(m2, 1)); m2 = fmaxf(m2, __shfl_xor(m2, 2)); m2 = fmaxf(m2, __shfl_xor(m2, 4));
                const float gs = m1 + m2;
                int grank = 0;
#pragma unroll
                for (int gg = 0; gg < 8; ++gg) { const float v = __uint_as_float(__builtin_amdgcn_readlane(__float_as_uint(gs), 8 * gg)); grank += ((v > gs) || (v == gs && gg < g)) ? 1 : 0; }
                const bool gok = grank < 4;
                const float val = gok ? ch : -__builtin_inff();
                int rank = 0;
#pragma unroll
                for (int e2 = 0; e2 < 64; ++e2) { const float v = __uint_as_float(__builtin_amdgcn_readlane(__float_as_uint(val), e2)); rank += ((v > val) || (v == val && e2 < lane)) ? 1 : 0; }
                const bool sel = gok && rank < TOPK;
                const float ssum = wave_sum(sel ? s : 0.f);
                gw2[rr] = s / ssum * 2.5f; sel2[rr] = sel;
                const unsigned long long selmask = __ballot(sel);
                jj2[rr] = __builtin_popcountll(selmask & ((1ull << lane) - 1ull)); }
#pragma unroll
            for (int rr = 0; rr < 2; ++rr) if (sel2[rr]) { const unsigned off = __hip_atomic_fetch_add((unsigned*)(lcnt + lane), 1u, __ATOMIC_RELAXED, __HIP_MEMORY_SCOPE_WORKGROUP);
                const int lrow = ltile * 16 + 2 * wave + rr; if (jj2[rr] < TOPK) { rrec[lrow * 8 + jj2[rr]] = ((unsigned)lane << 16) | off; rgw[lrow * 8 + jj2[rr]] = gw2[rr]; } }
        }
        __syncthreads();
        ++ltile;
    }
    if (pm == 0 || pm == 3) {
        if (tid < 64) lbase[tid] = __hip_atomic_fetch_add(counts + 16 * tid, lcnt[tid], __ATOMIC_RELAXED, __HIP_MEMORY_SCOPE_AGENT);
        __syncthreads();
        for (int i = tid; i < ltile * 128; i += NTHR) { const int lrow = i >> 3, j = i & 7; const unsigned rec = rrec[i]; const int e = (int)(rec >> 16), slot = (int)(lbase[e] + (rec & 0xffffu));
            const int grow = (t0 + (lrow >> 4)) * 16 + (lrow & 15);
            LTOK[e * T + slot] = grow; LW[e * T + slot] = rgw[i]; META[grow * TOPK + j] = ((unsigned)e << 16) | (unsigned)slot; }
    }
}

struct MUnit { int e, pos0, s0, nv, pn; };
constexpr int TL_OFF = 131072, SEGB_OFF = 131072 + 8192;
__device__ __forceinline__ int build_tiles(const unsigned* counts, LAS int* tl, LAS int* segb, int xg, const int g_wv, const bool want_tiles) {
    const int tid = TIDX, lane = tid & 63;
    LAS int* ntl = segb + 80;
    if (tid < 64) {
        const int cnt = (int)__hip_atomic_load(counts + 16 * lane, __ATOMIC_RELAXED, __HIP_MEMORY_SCOPE_AGENT);
        const int nt = (cnt + 255) >> 8;
        int inc = nt;
#pragma unroll
        for (int o = 1; o < 64; o <<= 1) { const int v = __shfl_up(inc, o); if (lane >= o) inc += v; }
        const int st = inc - nt;
        segb[lane] = st * 256;
        if (want_tiles) {
            int rank = 0;
#pragma unroll
            for (int e2 = 0; e2 < 64; ++e2) { const int v = __builtin_amdgcn_readlane(nt, e2); rank += ((v > nt) || (v == nt && e2 < lane)) ? 1 : 0; }
            ntl[rank] = nt;
            asm volatile("s_waitcnt lgkmcnt(0)" ::: "memory");
            const int k = rank >> 3, q = rank & 7, grp = (k & 1) ? 7 - q : q;
            int loc = 0, tot = 0;
#pragma unroll
            for (int j = 0; j < 8; ++j) { const int v = ntl[8 * j + ((j & 1) ? 7 - grp : grp)]; if (j < k) loc += v; }
            { const int g = lane & 7;
#pragma unroll
              for (int j = 0; j < 8; ++j) tot += ntl[8 * j + ((j & 1) ? 7 - g : g)]; }
            int totg[8], mn = 1 << 30;
#pragma unroll
            for (int g = 0; g < 8; ++g) { totg[g] = __builtin_amdgcn_readlane(tot, g); mn = totg[g] < mn ? totg[g] : mn; }
            int L = mn;
            for (int it = 0; it < 4096; ++it) { int s = 0;
#pragma unroll
                for (int g = 0; g < 8; ++g) s += (L - totg[g]) > 0 ? (L - totg[g]) : 0;
                if (s >= 64) break; ++L; }
            int ns[8], sum = 0;
#pragma unroll
            for (int g = 0; g < 8; ++g) { ns[g] = (L - totg[g]) > 0 ? (L - totg[g]) : 0; sum += ns[g]; }
            int excess = sum - 64;
#pragma unroll
            for (int g = 0; g < 8; ++g) { if (excess > 0 && ns[g] > 0) { --ns[g]; --excess; } }
            int shstart = 0, mytot = 0, myns = 0;
#pragma unroll
            for (int g = 0; g < 8; ++g) { if (g < xg) shstart += ns[g]; if (g == xg) { mytot = totg[g]; myns = ns[g]; } }
            if (grp == xg) for (int t = 0; t < nt; ++t) { const int nv = (cnt - 256 * t) < 256 ? (cnt - 256 * t) : 256; tl[2 * (loc + t)] = lane | (nv << 8) | (t << 18); tl[2 * (loc + t) + 1] = st * 256 + 256 * t; }
            if (lane < myns) { const int mt = shstart + lane; tl[2 * (mytot + lane)] = 64 | (256 << 8) | (mt << 18); tl[2 * (mytot + lane) + 1] = SH_POS0 + 256 * mt; }
            if (lane == 0) segb[64] = mytot + myns;
        }
    }
    __syncthreads();
    return want_tiles ? __builtin_amdgcn_readfirstlane(segb[64]) : 0;
}
template <bool GATHER, int NPNS  >
struct MoeOrder {
    typedef MUnit Unit;
    const LAS int* tl; int ntile, j, stride, K; const int* ltok;
    __device__ __forceinline__ bool next(int i, MUnit& u) const {
        const int idx = j + stride * i, tile = idx >> NPNS; if (tile >= ntile) return false;
        const int w0 = tl[2 * tile], w1 = tl[2 * tile + 1];
        u.e = w0 & 0xff; u.nv = (w0 >> 8) & 0x3ff; u.s0 = (w0 >> 18) << 8; u.pos0 = w1; u.pn = idx & ((1 << NPNS) - 1); return true;
    }
    __device__ __forceinline__ void a_offs(const MUnit& u, int tid, unsigned (&ao)[2][2]) const {
        int lt[2][2] = {{0, 0}, {0, 0}};
        if (GATHER) {
            const int* lte = ltok + (u.e < 64 ? u.e : 63) * T + u.s0; const int rmax = u.nv - 1;
#pragma unroll
            for (int i = 0; i < 2; ++i) { int R, C; pg8::stage_rc(tid * 16 + i * 8192, R, C);
#pragma unroll
                for (int h = 0; h < 2; ++h) { const int r = h * 128 + R; lt[h][i] = lte[r < rmax ? r : rmax]; } }
            asm volatile("" : "+v"(lt[0][0]), "+v"(lt[0][1]), "+v"(lt[1][0]), "+v"(lt[1][1]));
        }
#pragma unroll
        for (int i = 0; i < 2; ++i) { int R, C; pg8::stage_rc(tid * 16 + i * 8192, R, C);
#pragma unroll
            for (int h = 0; h < 2; ++h) { const int r = h * 128 + R;
                if (GATHER) { const int tok = (u.e != 64) ? ((r < u.nv) ? lt[h][i] : 0) : (u.s0 + r); ao[h][i] = (unsigned)((tok * K + C) * 2); }
                else ao[h][i] = (unsigned)(((u.pos0 + r) * K + C) * 2); } }
    }
    __device__ __forceinline__ size_t b_off(const MUnit& u) const { return (size_t)((GATHER ? u.e * 1024 : u.e * 2048) + u.pn * 256) * K * 2; }
    static constexpr bool LANE_CONST = !GATHER;
    __device__ __forceinline__ unsigned a_base(const MUnit& u) const { return (unsigned)u.pos0 * (unsigned)(K * 2); }
    __device__ __forceinline__ void a_lane(int tid, unsigned (&vo)[2]) const {
#pragma unroll
        for (int i = 0; i < 2; ++i) { int R, C; pg8::stage_rc(tid * 16 + i * 8192, R, C); vo[i] = (unsigned)((R * K + C) * 2); }
    }
};
struct EpiGateUp {
    static constexpr int PERM = 1; static constexpr bool FP8 = true;
    unsigned char* ACT; const float* lw;
    __device__ __forceinline__ void operator()(const f32x4 (&acc)[2][2][4][2], const MUnit& u, int wr, int wc, int fr, int fq) const {
        float gwv[2][4];
        { const float* lwe = lw + (size_t)(u.e < 64 ? u.e : 63) * T + u.s0; const int rmax = u.nv - 1;
#pragma unroll
          for (int ai = 0; ai < 2; ++ai)
#pragma unroll
            for (int m = 0; m < 4; ++m) { const int r = ai * 128 + wr * 64 + m * 16 + fr; gwv[ai][m] = lwe[r < rmax ? r : rmax]; } }
#pragma unroll
        for (int ai = 0; ai < 2; ++ai)
#pragma unroll
            for (int m = 0; m < 4; ++m) { const int r = ai * 128 + wr * 64 + m * 16 + fr;
                const float gw = ((u.e != 64) ? ((r < u.nv) ? gwv[ai][m] : 0.f) : 1.0f) * (ASCALE / WSCALE);
                const f32x4 g0 = acc[ai][0][m][0] * (1.0f / WSCALE), g1 = acc[ai][0][m][1] * (1.0f / WSCALE), u0 = acc[ai][1][m][0], u1 = acc[ai][1][m][1];
                u32x2 w;
#define ACT8(g_, u_) __builtin_amdgcn_fmed3f(silu_f(g_) * (u_) * gw, -448.0f, 448.0f)
                w.x = pk_fp8x4(ACT8(g0.x, u0.x), ACT8(g0.y, u0.y), ACT8(g0.z, u0.z), ACT8(g0.w, u0.w));
                w.y = pk_fp8x4(ACT8(g1.x, u1.x), ACT8(g1.y, u1.y), ACT8(g1.z, u1.z), ACT8(g1.w, u1.w));
#undef ACT8
                *(GAS u32x2*)(ACT + (size_t)(u.pos0 + r) * FE + u.pn * 128 + wc * 32 + 8 * fq) = w; }
    }
};
struct EpiDown {
    static constexpr int PERM = 3; static constexpr bool FP8 = true;
    unsigned char* OUT; float* X1; const float* modv; int skip_shared;
    __device__ __forceinline__ void operator()(const f32x4 (&acc)[2][2][4][2], const MUnit& u, int wr, int wc, int fr, int fq) const {
        const int col0 = u.pn * 256 + wc * 64 + 16 * fq;
        if (u.e == 64 && skip_shared) return;
        if (u.e != 64) {
#pragma unroll
            for (int ai = 0; ai < 2; ++ai)
#pragma unroll
                for (int m = 0; m < 4; ++m) { const int r = ai * 128 + wr * 64 + m * 16 + fr; unsigned char* rowp = OUT + (size_t)(u.pos0 + r) * D + col0;
                    constexpr float DS = 1.0f / (WSCALE * ASCALE);
                    const f32x4 a0 = acc[ai][0][m][0] * DS, a1 = acc[ai][0][m][1] * DS, b0 = acc[ai][1][m][0] * DS, b1 = acc[ai][1][m][1] * DS;
                    u32x4 w; w.x = pk_fp8x4(a0.x, a0.y, a0.z, a0.w); w.y = pk_fp8x4(a1.x, a1.y, a1.z, a1.w); w.z = pk_fp8x4(b0.x, b0.y, b0.z, b0.w); w.w = pk_fp8x4(b1.x, b1.y, b1.z, b1.w);
                    __builtin_nontemporal_store(w, (GAS u32x4*)rowp); }
        } else {
            const int b = u.s0 >> 12;
            f32x4 gv[2][2];
#pragma unroll
            for (int bj = 0; bj < 2; ++bj)
#pragma unroll
                for (int n = 0; n < 2; ++n) gv[bj][n] = *(const GAS f32x4*)(modv + b * 16384 + 10240 + col0 + bj * 8 + 4 * n) * (1.0f / (WSCALE * ASCALE));
#pragma unroll
            for (int ai = 0; ai < 2; ++ai) {
                f32x4 xv[4][2][2];
#pragma unroll
                for (int m = 0; m < 4; ++m) { const int r = ai * 128 + wr * 64 + m * 16 + fr; const float* rowp = X1 + (size_t)(u.s0 + r) * D + col0;
#pragma unroll
                    for (int bj = 0; bj < 2; ++bj)
#pragma unroll
                        for (int n = 0; n < 2; ++n) xv[m][bj][n] = *(const GAS f32x4*)(rowp + bj * 8 + 4 * n); }
#pragma unroll
                for (int m = 0; m < 4; ++m) { const int r = ai * 128 + wr * 64 + m * 16 + fr; float* rowp = X1 + (size_t)(u.s0 + r) * D + col0;
#pragma unroll
                    for (int bj = 0; bj < 2; ++bj)
#pragma unroll
                        for (int n = 0; n < 2; ++n) *(GAS f32x4*)(rowp + bj * 8 + 4 * n) = xv[m][bj][n] + gv[bj][n] * acc[ai][bj][m][n]; }
            }
        }
    }
};

__device__ __forceinline__ void p8_final(const Args& a, LAS unsigned char* lds, const int g_wv, float* Xo) {
    const int tid = TIDX, lane = tid & 63, wave = g_wv;
    const int gw = blockIdx.x * NWAVES + wave, NGW = gridDim.x * NWAVES;
    const float* modv = (const float*)(a.ws + WS_MOD); const unsigned char* OUT = (const unsigned char*)(a.ws + WS_OUT); const unsigned* META = (const unsigned*)(a.ws + WS_META);
    float* X = a.out;
    LAS int* tl = (LAS int*)(lds + TL_OFF); LAS int* segb = (LAS int*)(lds + SEGB_OFF);
    (void)build_tiles((const unsigned*)(a.ws + WS_CTL) + CW_CNT, tl, segb, (int)(blockIdx.x & 7), g_wv, false);
    f32x4 A[8], B[8], G2[8]; int curb = -1;
    for (int row = (int)((long)gw * T / NGW), rowe = (int)((long)(gw + 1) * T / NGW); row < rowe; ++row) {
        const int b = row >> 12;
        if (b != curb) { curb = b;
#pragma unroll
            for (int i = 0; i < 8; ++i) { const int d = 4 * lane + 256 * i; const f32x4 g = *(const GAS f32x4*)(a.in[I_NFG] + d), sc = *(const GAS f32x4*)(modv + b * 16384 + 14336 + d);
                A[i] = g * (1.0f + sc); B[i] = *(const GAS f32x4*)(modv + b * 16384 + 12288 + d); G2[i] = *(const GAS f32x4*)(modv + b * 16384 + 10240 + d); } }
        f32x4 y[8];
#pragma unroll
        for (int i = 0; i < 8; ++i) y[i] = (f32x4){0.f, 0.f, 0.f, 0.f};
        const u32x4 m0 = *(const GAS u32x4*)(META + (size_t)row * 8), m1 = *(const GAS u32x4*)(META + (size_t)row * 8 + 4);
        const unsigned mm[8] = {m0.x, m0.y, m0.z, m0.w, m1.x, m1.y, m1.z, m1.w};
#pragma unroll
        for (int k = 0; k < 8; ++k) { const int e = (int)(mm[k] >> 16) & 63, slot = (int)(mm[k] & 0xffffu); const unsigned char* orow = OUT + (size_t)(segb[e] + slot) * D + 4 * lane;
#pragma unroll
            for (int i = 0; i < 8; ++i) { const unsigned w = __builtin_nontemporal_load((const GAS unsigned*)(orow + 256 * i));
                const f32x2 lo = __builtin_amdgcn_cvt_pk_f32_fp8((int)w, false), hi = __builtin_amdgcn_cvt_pk_f32_fp8((int)w, true);
                y[i] += (f32x4){lo.x, lo.y, hi.x, hi.y}; } }
        float ss = 0.f; f32x4 v[8];
#pragma unroll
        for (int i = 0; i < 8; ++i) { const f32x4 xv = *(const GAS f32x4*)(X + (size_t)row * D + 4 * lane + 256 * i); v[i] = xv + G2[i] * y[i];
            ss += (v[i].x * v[i].x + v[i].y * v[i].y) + (v[i].z * v[i].z + v[i].w * v[i].w); }
        const float rstd = __builtin_amdgcn_rsqf(wave_sum(ss) * (1.0f / D) + EPS);
#pragma unroll
        for (int i = 0; i < 8; ++i) __builtin_nontemporal_store(v[i] * rstd * A[i] + B[i], (GAS f32x4*)(Xo + (size_t)row * D + 4 * lane + 256 * i));
    }
}

__global__ void __launch_bounds__(NTHR, 2) fwd_kernel(Args args) {
    extern __shared__ __attribute__((aligned(16))) unsigned char lds_raw[];
    LAS unsigned char* lds = (LAS unsigned char*)lds_raw;
    const int g_wv = __builtin_amdgcn_readfirstlane((int)threadIdx.x >> 6);
    { const int tid = TIDX; for (int u = tid; u < 256; u += NTHR) ((LAS unsigned*)(lds + LDSCTL_OFF))[u] = 0u; }
    __syncthreads();
    if (TIDX == 0) { LAS unsigned long long* pt = (LAS unsigned long long*)(lds + LDSCTL_OFF + 256);
        pt[0] = (unsigned long long)(uintptr_t)args.in[I_WIN]; pt[1] = (unsigned long long)(uintptr_t)args.in[I_WOUT]; pt[2] = (unsigned long long)(uintptr_t)args.in[I_WG]; pt[3] = (unsigned long long)(uintptr_t)args.in[I_WU];
        pt[4] = (unsigned long long)(uintptr_t)args.in[I_WDN]; pt[5] = (unsigned long long)(uintptr_t)args.in[I_SG]; pt[6] = (unsigned long long)(uintptr_t)args.in[I_SU]; pt[7] = (unsigned long long)(uintptr_t)args.in[I_SD]; }
    __syncthreads();
    unsigned* ctl = (unsigned*)(args.ws + WS_CTL);
    const int lo = args.ph_lo, hi = args.ph_hi;
    XcdBarrier bar; bar.bar = ctl + CW_BAR; bar.x = 0; bar.st = nullptr;
    if (hi - lo > 1) bar = xcd_barrier_post(ctl + CW_BAR, (volatile LAS unsigned*)(lds + LDSCTL_OFF) + 8, g_wv);
#define IN(k) (lo <= (k) && (k) < hi)
#define SEAM(k) do { if (IN(k) && IN((k) + 1)) xcd_barrier(bar, g_wv); } while (0)
    float* modv = (float*)(args.ws + WS_MOD);
#define DUP(k) (DUP_PHASE == (k))
    if (IN(0)) { p0_prologue(args, lds, g_wv); if (DUP(0)) { xcd_barrier(bar, g_wv); p0_prologue(args, lds, g_wv); } } SEAM(0);
    if (IN(1)) { norm_rows_bf16<true>(args.in[I_X], args.in[I_N1G], modv, 0, 2048, (bf16*)(args.ws + WS_H1), g_wv);
        if (DUP(1)) { xcd_barrier(bar, g_wv); norm_rows_bf16<true>(args.in[I_X], args.in[I_N1G], modv, 0, 2048, (bf16*)(args.ws + WS_H1), g_wv); } } SEAM(1);
    if (IN(2)) {
        const int nu = (1792 + (int)gridDim.x - 1) / (int)gridDim.x, s = (int)(blockIdx.x % (unsigned)(nu > 0 ? nu : 1));
        { pg8::DenseOrder S1; S1.init(T, INC, D / 2, (int)gridDim.x, (int)blockIdx.x); S1.cnt = s; EpiQKV E1{(bf16*)(args.ws + WS_U), (const float*)(args.ws + WS_ROPE), 0};
          pg8::gemm_phase<pg8::DenseOrder, EpiQKV, true, true>(lds, (const char*)(args.ws + WS_H1), (const char*)(args.ws + WS_WIN), D / 2, S1, E1, g_wv); }
        cvt_run<true>(args.ws, lds, g_wv, CV_EARLY, CV_SPLIT); __syncthreads();
        { pg8::DenseOrder S2; S2.init(T, INC, D / 2, (int)gridDim.x, (int)blockIdx.x); S2.i0 = s; EpiQKV E2{(bf16*)(args.ws + WS_U), (const float*)(args.ws + WS_ROPE), 0};
          pg8::gemm_phase<pg8::DenseOrder, EpiQKV, true, true>(lds, (const char*)(args.ws + WS_H1), (const char*)(args.ws + WS_WIN), D / 2, S2, E2, g_wv); }
        if (DUP(2)) { xcd_barrier(bar, g_wv); pg8::DenseOrder S; S.init(T, INC, D / 2, (int)gridDim.x, (int)blockIdx.x); EpiQKV E{(bf16*)(args.ws + WS_U), (const float*)(args.ws + WS_ROPE), 0};
            pg8::gemm_phase<pg8::DenseOrder, EpiQKV, true, true>(lds, (const char*)(args.ws + WS_H1), (const char*)(args.ws + WS_WIN), D / 2, S, E, g_wv); }
    } SEAM(2);
    if (IN(3)) { mix::p3_mixer(args, lds, (char*)lds_raw, g_wv, 0, 1, 0); if (DUP(3)) { xcd_barrier(bar, g_wv); mix::p3_mixer(args, lds, (char*)lds_raw, g_wv, 1024, 1, 0); } if (DUP(13)) { xcd_barrier(bar, g_wv); mix::p3_mixer(args, lds, (char*)lds_raw, g_wv, 1024, 0, 0); } if (DUP(16)) { xcd_barrier(bar, g_wv); mix::p3_mixer(args, lds, (char*)lds_raw, g_wv, 1024, 0, 1); } if (DUP(17)) { xcd_barrier(bar, g_wv); mix::p3_mixer(args, lds, (char*)lds_raw, g_wv, 1024, 0, 2); } if (DUP(18)) { xcd_barrier(bar, g_wv); mix::p3_mixer(args, lds, (char*)lds_raw, g_wv, 1024, 0, 3); } if (DUP(19)) { xcd_barrier(bar, g_wv); mix::p3_mixer(args, lds, (char*)lds_raw, g_wv, 1024, 0, 4); } if (DUP(20)) { xcd_barrier(bar, g_wv); mix::p3_mixer(args, lds, (char*)lds_raw, g_wv, 1024, 0, 5); } if (DUP(15)) { xcd_barrier(bar, g_wv); mix::p3_mixer(args, lds, (char*)lds_raw, g_wv, 1024, 3, 0); }
        xcd_barrier(bar, g_wv); mix::p3_ret_chunks(args, (char*)lds_raw, g_wv); if (DUP(14)) { xcd_barrier(bar, g_wv); mix::p3_ret_chunks(args, (char*)lds_raw, g_wv); } } SEAM(3);
    if (IN(4)) { pg8::DenseOrder S; S.init(T, D, D / 2, (int)gridDim.x, (int)blockIdx.x);
        EpiResid E{args.in[I_X], args.out, modv};
        pg8::gemm_phase<pg8::DenseOrder, EpiResid, true, true>(lds, (const char*)(args.ws + WS_H1), (const char*)(args.ws + WS_WOUT), D / 2, S, E, g_wv);
        if (DUP(4)) { xcd_barrier(bar, g_wv); pg8::gemm_phase<pg8::DenseOrder, EpiResid, true, true>(lds, (const char*)(args.ws + WS_H1), (const char*)(args.ws + WS_WOUT), D / 2, S, E, g_wv); } } SEAM(4);
    if (IN(5)) { if (DUP(5)) { p5_router(args, lds, g_wv, 2048, 3); xcd_barrier(bar, g_wv); } if (DUP(51)) { p5_router(args, lds, g_wv, 2048, 1); xcd_barrier(bar, g_wv); } if (DUP(52)) { p5_router(args, lds, g_wv, 2048, 2); xcd_barrier(bar, g_wv); } p5_router(args, lds, g_wv, 0, 0); } SEAM(5);
    if (IN(6)) { LAS int* tl = (LAS int*)(lds + TL_OFF); LAS int* segb = (LAS int*)(lds + SEGB_OFF);
        const int ntile = build_tiles(ctl + CW_CNT, tl, segb, (int)(blockIdx.x & 7), g_wv, true);
        MoeOrder<true, 2> S{tl, ntile, (int)(blockIdx.x >> 3), (int)(gridDim.x >> 3), D / 2, (const int*)(args.ws + WS_LTOK)};
        EpiGateUp E{args.ws + WS_ACT, (const float*)(args.ws + WS_LW)};
        pg8::gemm_phase<MoeOrder<true, 2>, EpiGateUp, true, true>(lds, (const char*)(args.ws + WS_U), (const char*)(args.ws + WS_WGU), D / 2, S, E, g_wv);
        if (DUP(6)) { xcd_barrier(bar, g_wv); pg8::gemm_phase<MoeOrder<true, 2>, EpiGateUp, true, true>(lds, (const char*)(args.ws + WS_U), (const char*)(args.ws + WS_WGU), D / 2, S, E, g_wv); }
        if (DUP(61)) { pg8::gemm_phase<MoeOrder<true, 2>, EpiGateUp, true, true, 1>(lds, (const char*)(args.ws + WS_U), (const char*)(args.ws + WS_WGU), D / 2, S, E, g_wv); xcd_barrier(bar, g_wv); pg8::gemm_phase<MoeOrder<true, 2>, EpiGateUp, true, true>(lds, (const char*)(args.ws + WS_U), (const char*)(args.ws + WS_WGU), D / 2, S, E, g_wv); }
        if (DUP(62)) { pg8::gemm_phase<MoeOrder<true, 2>, EpiGateUp, true, true, 2>(lds, (const char*)(args.ws + WS_U), (const char*)(args.ws + WS_WGU), D / 2, S, E, g_wv); xcd_barrier(bar, g_wv); pg8::gemm_phase<MoeOrder<true, 2>, EpiGateUp, true, true>(lds, (const char*)(args.ws + WS_U), (const char*)(args.ws + WS_WGU), D / 2, S, E, g_wv); } } SEAM(6);
    if (IN(7)) { LAS int* tl = (LAS int*)(lds + TL_OFF); LAS int* segb = (LAS int*)(lds + SEGB_OFF);
        const int ntile = build_tiles(ctl + CW_CNT, tl, segb, (int)(blockIdx.x & 7), g_wv, true);
        MoeOrder<false, 3> S{tl, ntile, (int)(blockIdx.x >> 3), (int)(gridDim.x >> 3), FE / 2, nullptr};
        if (DUP(7)) { EpiDown E0{(unsigned char*)(args.ws + WS_OUT), args.out, modv, 1};
            pg8::gemm_phase<MoeOrder<false, 3>, EpiDown, true, true>(lds, (const char*)(args.ws + WS_ACT), (const char*)(args.ws + WS_WD), FE / 2, S, E0, g_wv); xcd_barrier(bar, g_wv); }
        EpiDown E{(unsigned char*)(args.ws + WS_OUT), args.out, modv, 0};
        pg8::gemm_phase<MoeOrder<false, 3>, EpiDown, true, true>(lds, (const char*)(args.ws + WS_ACT), (const char*)(args.ws + WS_WD), FE / 2, S, E, g_wv); } SEAM(7);
    if (DUP(99)) { for (int q = 0; q < 10; ++q) xcd_barrier(bar, g_wv); }
    if (IN(8)) { if (DUP(8)) { p8_final(args, lds, g_wv, (float*)(args.ws + WS_ACT)); xcd_barrier(bar, g_wv); } p8_final(args, lds, g_wv, args.out); }
#undef IN
#undef SEAM
}

#ifndef MK_ONE_LAUNCH
#define MK_ONE_LAUNCH 1
#endif
extern "C" void kernel_launch(void* const* d_in, const int* in_sizes, int n_in, void* d_out, int out_size, void* d_ws, size_t ws_size, hipStream_t stream) {
    static int grid = 0;
    if (grid == 0) {
        if (n_in != 20 || out_size != T * D || ws_size < WS_END) { fprintf(stderr, "kernel_launch: unexpected shapes (n_in %d out %d ws %zu need %zu)\n", n_in, out_size, ws_size, (size_t)WS_END); grid = -1; return; }
        int dev = 0, cus = 0, per_cu = 0;
        if (hipGetDevice(&dev) != hipSuccess || hipDeviceGetAttribute(&cus, hipDeviceAttributeMultiprocessorCount, dev) != hipSuccess) { grid = -1; return; }
        if (hipFuncSetAttribute((const void*)fwd_kernel, hipFuncAttributeMaxDynamicSharedMemorySize, LDS_BYTES) != hipSuccess) { fprintf(stderr, "kernel_launch: hipFuncSetAttribute failed\n"); grid = -1; return; }
        if (hipOccupancyMaxActiveBlocksPerMultiprocessor(&per_cu, (const void*)fwd_kernel, NTHR, LDS_BYTES) != hipSuccess || per_cu < 1) fprintf(stderr, "kernel_launch: occupancy query says %d\n", per_cu);
        (void)hipGetLastError();
        grid = cus & ~7;
        if (grid < 128) { fprintf(stderr, "kernel_launch: %d CUs: this kernel is built for a 256-CU MI355X (needs >= 128)\n", cus); grid = -1; return; }
    }
    if (grid < 0) return;
    (void)hipMemsetAsync((char*)d_ws + WS_CTL, 0, CTL_ZERO_BYTES, stream);
    Args a{};
    for (int i = 0; i < 20; ++i) a.in[i] = (const float*)d_in[i];
    a.out = (float*)d_out; a.ws = (unsigned char*)d_ws;
#if MK_ONE_LAUNCH
    a.ph_lo = 0; a.ph_hi = NPH;
    hipLaunchKernelGGL(fwd_kernel, dim3(grid), dim3(NTHR), LDS_BYTES, stream, a);
#else
    for (int p = 0; p < NPH; ++p) { a.ph_lo = p; a.ph_hi = p + 1; hipLaunchKernelGGL(fwd_kernel, dim3(grid), dim3(NTHR), LDS_BYTES, stream, a); }
#endif
}
```

```cpp
#include <hip/hip_runtime.h>
#include <cstdio>
#include <cstdint>

#define GAS __attribute__((address_space(1)))
#define LAS __attribute__((address_space(3)))
typedef unsigned short bf16;
typedef float f32x2 __attribute__((ext_vector_type(2)));
typedef float f32x4 __attribute__((ext_vector_type(4)));
typedef float f32x16 __attribute__((ext_vector_type(16)));
typedef short bf16x8 __attribute__((ext_vector_type(8)));
typedef short s16x4 __attribute__((ext_vector_type(4)));
typedef unsigned u32x2 __attribute__((ext_vector_type(2)));
typedef unsigned u32x4 __attribute__((ext_vector_type(4)));
typedef int v8i_t __attribute__((ext_vector_type(8)));

constexpr int NB = 4, SEQ = 4096, T = NB * SEQ, D = 2048, HD = 128, NH = 8, INC = 7168, NE = 64, FE = 512, TOPK = 8;
constexpr float EPS = 1e-6f;
constexpr float LOG2E = 1.4426950408889634f;
constexpr float RSQ_HD = 0.08838834764831845f;
constexpr int NWAVES = 8, NTHR = 512;
#ifndef DUP_PHASE
#define DUP_PHASE -1
#endif
constexpr int NPH = 9;

constexpr size_t MiB = 1u << 20;
constexpr size_t WS_CTL = 0, CTL_ZERO_BYTES = 1 * MiB;
constexpr size_t WS_MOD = 1 * MiB;
constexpr size_t WS_META = WS_MOD + 512 * 1024;
constexpr size_t WS_ROPE = 2 * MiB;
constexpr size_t WS_LTOK = 4 * MiB;
constexpr size_t WS_LW = 8 * MiB;
constexpr size_t WS_WIN = 12 * MiB;
constexpr size_t WS_WOUT = 40 * MiB;
constexpr size_t WS_WD = 48 * MiB;
constexpr size_t WS_ACT = 178 * MiB;
constexpr size_t WS_BIG = 338 * MiB;
constexpr size_t WS_WGU = WS_BIG;
constexpr size_t WS_H1 = WS_BIG + 260 * MiB;
constexpr size_t WS_U = WS_BIG + 324 * MiB;
constexpr size_t WS_X1B = WS_BIG + 388 * MiB;
constexpr size_t WS_OUT = WS_BIG;
constexpr size_t WS_WR = WS_BIG + 576 * MiB;
constexpr size_t WS_END = WS_WR + 1 * MiB;
constexpr int SH_POS0 = 147456;
static_assert(WS_WGU + (size_t)65 * 1024 * 2048 * 2 <= WS_H1 && WS_H1 + (size_t)T * D * 2 <= WS_U && WS_U + (size_t)T * INC * 2 <= WS_WR, "ws map");
static_assert(WS_WD + (size_t)65 * 2048 * 512 * 2 <= WS_ACT && WS_ACT + (size_t)163840 * 512 * 2 <= WS_BIG && WS_OUT + (size_t)147456 * 2048 * 2 <= WS_WR, "ws map");
constexpr int CW_BAR = 1024, CW_QHEAD = 16384, CW_CNT = 8256, CW_CVQ = 20480;

constexpr int SCR_BYTES = 147456;
constexpr int LDSCTL_OFF = SCR_BYTES;
constexpr int STASH_OFF = SCR_BYTES + 1024;
constexpr int LDS_BYTES = 163840;
constexpr int XCH_OFF = STASH_OFF, XCH_LAST_OFF = 131072 + 8192 + 1024;
static_assert(XCH_OFF + 7 * 2048 <= LDS_BYTES && XCH_LAST_OFF + 2048 <= SCR_BYTES, "lds map");

#define LDS_WAIT() asm volatile("s_waitcnt lgkmcnt(0)" ::: "memory")
#define VM_WAIT() asm volatile("s_waitcnt vmcnt(0)" ::: "memory")
#define SBAR() __builtin_amdgcn_sched_barrier(0)
typedef __bf16 bf16x2_t __attribute__((ext_vector_type(2)));
__device__ __forceinline__ unsigned cvtpk(float lo, float hi) { const f32x2 v = {lo, hi}; const bf16x2_t r = __builtin_convertvector(v, bf16x2_t); return __builtin_bit_cast(unsigned, r); }
__device__ __forceinline__ unsigned pk_fp8x4(float a, float b, float c, float d) { int w = 0; w = __builtin_amdgcn_cvt_pk_fp8_f32(a, b, w, false); w = __builtin_amdgcn_cvt_pk_fp8_f32(c, d, w, true); return (unsigned)w; }
__device__ __forceinline__ float bf2f(unsigned short b) { return __uint_as_float(((unsigned)b) << 16); }
__device__ __forceinline__ float bflo(unsigned w) { return __uint_as_float(w << 16); }
__device__ __forceinline__ float bfhi(unsigned w) { return __uint_as_float(w & 0xffff0000u); }
__device__ __forceinline__ float wave_sum(float v) {
#pragma unroll
    for (int o = 1; o < 64; o <<= 1) v += __shfl_xor(v, o);
    return v;
}
__device__ __forceinline__ int lane_now() { int l; asm volatile("v_mbcnt_lo_u32_b32 %0, -1, 0\n\tv_mbcnt_hi_u32_b32 %0, -1, %0" : "=v"(l)); return l; }
#define TIDX (g_wv * 64 + lane_now())
__device__ __forceinline__ float fast_rcp(float x) { return __builtin_amdgcn_rcpf(x); }
__device__ __forceinline__ float fast_exp2(float x) { return __builtin_amdgcn_exp2f(x); }
__device__ __forceinline__ float silu_f(float x) { return x * fast_rcp(1.0f + fast_exp2(-x * LOG2E)); }

#define XB_TMO      128
#define XB_XCNT(j)  (256  + 64 * (j))
#define XB_XSUB(j)  (1280 + 64 * (j))
#define XB_XGEN(j)  (2304 + 64 * (j))
#define XB_TOP      3328
#define XB_TOPGEN   3392
#define XCD_BAR_WORDS 3456
#define XB_SPIN_CAP (1u << 18)
__device__ __forceinline__ unsigned xb_ld(unsigned* p)              { return __hip_atomic_load(p, __ATOMIC_RELAXED, __HIP_MEMORY_SCOPE_AGENT); }
__device__ __forceinline__ unsigned xb_add(unsigned* p, unsigned v) { return __hip_atomic_fetch_add(p, v, __ATOMIC_RELAXED, __HIP_MEMORY_SCOPE_AGENT); }
__device__ __forceinline__ unsigned xb_xcc_id() { return (unsigned)__builtin_amdgcn_s_getreg((3 << 11) | 20) & 0xFu; }
#define XB_SPIN(cond, bar) do { unsigned _sp = 0; while (cond) { __builtin_amdgcn_s_sleep(1); \
    if ((++_sp & 255u) == 0u) { if (xb_ld(&(bar)[XB_TMO])) break; if (_sp > XB_SPIN_CAP) { atomicAdd(&(bar)[XB_TMO], 1u); break; } } } } while (0)
struct XcdBarrier { unsigned* bar; unsigned x; volatile LAS unsigned* st; };
__device__ __forceinline__ XcdBarrier xcd_barrier_post(unsigned* bar, volatile LAS unsigned* st, const int g_wv) {
    XcdBarrier b; b.bar = bar; b.x = xb_xcc_id(); b.st = st;
    if (TIDX == 0) (void)xb_add(&bar[XB_XCNT(b.x)], 1u);
    return b;
}
__device__ __forceinline__ void xcd_barrier_complete(unsigned* bar, unsigned x, unsigned& nloc, unsigned& nx) {
    const unsigned G = gridDim.x * gridDim.y * gridDim.z;
    unsigned sum, cnt, mine, sp = 0u;
    for (;;) {
        sum = 0u; cnt = 0u; mine = 0u;
#pragma unroll
        for (unsigned j = 0; j < 16; ++j) { const unsigned c = xb_ld(&bar[XB_XCNT(j)]); sum += c; cnt += (c > 0u) ? 1u : 0u; mine = (j == x) ? c : mine; }
        if (sum == G) break;
        __builtin_amdgcn_s_sleep(1);
        if ((++sp & 255u) == 0u) { if (xb_ld(&bar[XB_TMO])) break; if (sp > XB_SPIN_CAP) { atomicAdd(&bar[XB_TMO], 1u); break; } }
    }
    nloc = mine > 0u ? mine : 1u; nx = cnt > 0u ? cnt : 1u;
}
__device__ __forceinline__ void xcd_barrier(const XcdBarrier& b, const int g_wv) {
    asm volatile("s_waitcnt vmcnt(0)" ::: "memory");
    __syncthreads();
    if (TIDX == 0) {
        unsigned* bar = b.bar;
        __builtin_amdgcn_s_waitcnt(0);
        unsigned nloc = b.st[0], nx = b.st[1];
        if (nloc == 0u) { xcd_barrier_complete(bar, b.x, nloc, nx); b.st[0] = nloc; b.st[1] = nx; }
        const unsigned old = xb_add(&bar[XB_XSUB(b.x)], 1u);
        const unsigned gen = old / nloc;
        if (old + 1u == (gen + 1u) * nloc) {
            __builtin_amdgcn_fence(__ATOMIC_RELEASE, "agent");
            asm volatile("s_waitcnt vmcnt(0)" ::: "memory");
            const unsigned og = xb_add(&bar[XB_TOP], 1u);
            const unsigned tg = og / nx;
            if (og + 1u == (tg + 1u) * nx) xb_add(&bar[XB_TOPGEN], 1u);
            else XB_SPIN(xb_ld(&bar[XB_TOPGEN]) == tg, bar);
            __builtin_amdgcn_fence(__ATOMIC_ACQUIRE, "agent");
            xb_add(&bar[XB_XGEN(b.x)], 1u);
            asm volatile("s_waitcnt vmcnt(0)" ::: "memory");
        } else {
            XB_SPIN(xb_ld(&bar[XB_XGEN(b.x)]) == gen, bar);
            __builtin_amdgcn_fence(__ATOMIC_ACQUIRE, "agent");
            asm volatile("s_waitcnt vmcnt(0)" ::: "memory");
        }
    }
    __syncthreads();
}

struct Args { const float* in[20]; float* out; unsigned char* ws; int ph_lo, ph_hi; };
enum { I_X = 0, I_C, I_WADA, I_BADA, I_N1G, I_WIN, I_RGN, I_WOUT, I_N2G, I_WR, I_RB, I_WG, I_WU, I_WDN, I_SG, I_SU, I_SD, I_WAF, I_BAF, I_NFG };

__constant__ float c_inv_freq[64] = {
1.0f, 0.865964353f, 0.749894202f, 0.649381638f, 0.562341332f, 0.486967534f, 0.421696514f, 0.365174115f, 0.316227764f, 0.273841977f, 0.237137377f, 0.2053525f, 0.177827939f, 0.153992653f, 0.133352146f, 0.115478195f,
0.100000001f, 0.0865964293f, 0.0749894232f, 0.0649381652f, 0.0562341325f, 0.0486967526f, 0.0421696492f, 0.0365174115f, 0.0316227749f, 0.0273841955f, 0.0237137377f, 0.0205352511f, 0.0177827943f, 0.0153992651f, 0.013335214f, 0.0115478197f,
0.00999999978f, 0.00865964312f, 0.00749894232f, 0.00649381615f, 0.00562341325f, 0.00486967526f, 0.00421696482f, 0.00365174119f, 0.00316227763f, 0.00273841969f, 0.00237137382f, 0.00205352507f, 0.00177827943f, 0.00153992651f, 0.00133352145f, 0.00115478202f,
0.00100000005f, 0.000865964335f, 0.000749894185f, 0.000649381604f, 0.000562341302f, 0.000486967532f, 0.000421696517f, 0.000365174114f, 0.000316227757f, 0.000273841957f, 0.00023713737f, 0.00020535251f, 0.00017782794f, 0.00015399266f, 0.00013335215f, 0.0001154782f };

template <int MODE> __device__ __forceinline__ int cvt_orow(int n) {
    if (MODE == 1) { const int grp = n >> 10; if (grp == 3 || grp == 4) { const int d = n & 127; return (n & ~127) + 2 * (d & 63) + (d >> 6); } return n; }
    if (MODE == 2) return ((n >> 7) << 8) + (n & 127);
    if (MODE == 3) return ((n >> 7) << 8) + 128 + (n & 127);
    return n;
}
template <int MODE> __device__ __forceinline__ void cvt_item(const float* W, int ldw, int k0, int n0, bf16* dst, int ldd, LAS float* scr, int lane) {
    const int n4 = lane & 15, kr = lane >> 4;
    f32x4 v[16];
#pragma unroll
    for (int i = 0; i < 16; ++i) v[i] = __builtin_nontemporal_load((const GAS f32x4*)(W + (size_t)(k0 + 4 * i + kr) * ldw + n0 + 4 * n4));
#pragma unroll
    for (int i = 0; i < 16; ++i) { LAS float* s = scr + (4 * i + kr) * 65 + 4 * n4; s[0] = v[i].x; s[1] = v[i].y; s[2] = v[i].z; s[3] = v[i].w; }
    LDS_WAIT(); asm volatile("" ::: "memory");
    const int kg = lane & 7, ns = lane >> 3;
#pragma unroll
    for (int j = 0; j < 8; ++j) { const int n = ns + 8 * j; const LAS float* s = scr + (8 * kg) * 65 + n;
        u32x4 o; o.x = cvtpk(s[0], s[65]); o.y = cvtpk(s[2 * 65], s[3 * 65]); o.z = cvtpk(s[4 * 65], s[5 * 65]); o.w = cvtpk(s[6 * 65], s[7 * 65]);
        *(GAS u32x4*)(dst + (size_t)cvt_orow<MODE>(n0 + n) * ldd + k0 + 8 * kg) = o; }
    LDS_WAIT(); asm volatile("" ::: "memory");
}
constexpr int CV_I0 = 32 * 112, CV_I1 = 32 * 32, CV_I2 = 64 * 32 * 8, CV_I4 = 64 * 8 * 32, CV_I5 = 32 * 8, CV_I7 = 8 * 32;
constexpr int CV_EARLY = CV_I0 + CV_I1, CV_SPLIT = CV_I0 + CV_I1 + 2 * CV_I2, CV_NIT = CV_I0 + CV_I1 + 2 * CV_I2 + CV_I4 + 2 * CV_I5 + CV_I7;
constexpr float WSCALE = 64.0f, ASCALE = 16.0f;
template <bool F8>
__device__ __forceinline__ void cvt_run(unsigned char* ws, LAS unsigned char* lds, const int g_wv, const int lo, const int hi, const int wg_local = 0) {
    const int tid = TIDX, lane = tid & 63, wave = g_wv, G = gridDim.x, bx = blockIdx.x;
    const volatile LAS unsigned long long* ptab = (const volatile LAS unsigned long long*)(lds + LDSCTL_OFF + 256);
    {
        LAS float* scr = (LAS float*)(lds + wave * 16640);
        const int gw = wg_local ? wave : bx * NWAVES + wave, NGW = wg_local ? NWAVES : G * NWAVES;
        bf16* Win = (bf16*)(ws + WS_WIN); bf16* Wout = (bf16*)(ws + WS_WOUT); unsigned char* Wgu8 = ws + WS_WGU; unsigned char* Wd8 = ws + WS_WD;
        constexpr int I0 = CV_I0, I1 = CV_I1, I2 = CV_I2, I4 = CV_I4, I5 = CV_I5; const int NIT = hi;
#define CVT_PTR(i_) ((const float*)(uintptr_t)ptab[i_])
        constexpr int KB_ = F8 ? 128 : 64, NW_ = F8 ? 32 : 64;
#define CVT_DEC(it_, W_, dst_, ldw_, ldd_, k0_, n0_, mode_) do { int r = (it_); \
            if (r < I0) { W_ = CVT_PTR(0); ldw_ = INC; k0_ = KB_ * (r / (INC / NW_)); n0_ = NW_ * (r % (INC / NW_)); dst_ = Win; ldd_ = D; mode_ = 1; } \
            else if ((r -= I0) < I1) { W_ = CVT_PTR(1); ldw_ = D; k0_ = KB_ * (r / (D / NW_)); n0_ = NW_ * (r % (D / NW_)); dst_ = Wout; ldd_ = D; mode_ = 0; } \
            else if ((r -= I1) < I2) { const int e = r >> 8, q = r & 255; W_ = CVT_PTR(2) + (size_t)e * D * FE; ldw_ = FE; k0_ = KB_ * (q / (FE / NW_)); n0_ = NW_ * (q % (FE / NW_)); dst_ = (bf16*)(Wgu8 + (size_t)e * 1024 * D); ldd_ = D; mode_ = 2; } \
            else if ((r -= I2) < I2) { const int e = r >> 8, q = r & 255; W_ = CVT_PTR(3) + (size_t)e * D * FE; ldw_ = FE; k0_ = KB_ * (q / (FE / NW_)); n0_ = NW_ * (q % (FE / NW_)); dst_ = (bf16*)(Wgu8 + (size_t)e * 1024 * D); ldd_ = D; mode_ = 3; } \
            else if ((r -= I2) < I4) { const int e = r >> 8, q = r & 255; W_ = CVT_PTR(4) + (size_t)e * FE * D; ldw_ = D; k0_ = KB_ * (q / (D / NW_)); n0_ = NW_ * (q % (D / NW_)); dst_ = (bf16*)(Wd8 + (size_t)e * D * FE); ldd_ = FE; mode_ = 0; } \
            else if ((r -= I4) < I5) { W_ = CVT_PTR(5); ldw_ = FE; k0_ = KB_ * (r / (FE / NW_)); n0_ = NW_ * (r % (FE / NW_)); dst_ = (bf16*)(Wgu8 + (size_t)64 * 1024 * D); ldd_ = D; mode_ = 2; } \
            else if ((r -= I5) < I5) { W_ = CVT_PTR(6); ldw_ = FE; k0_ = KB_ * (r / (FE / NW_)); n0_ = NW_ * (r % (FE / NW_)); dst_ = (bf16*)(Wgu8 + (size_t)64 * 1024 * D); ldd_ = D; mode_ = 3; } \
            else { r -= I5; W_ = CVT_PTR(7); ldw_ = D; k0_ = KB_ * (r / (D / NW_)); n0_ = NW_ * (r % (D / NW_)); dst_ = (bf16*)(Wd8 + (size_t)64 * D * FE); ldd_ = FE; mode_ = 0; } } while (0)
        const int n4 = F8 ? (lane & 7) : (lane & 15), kr = F8 ? (lane >> 3) : (lane >> 4), kg = lane & 7, ns = lane >> 3;
#define CVT_LOAD(V_, W_, ldw_, k0_, n0_) do { _Pragma("unroll") for (int i = 0; i < 16; ++i) V_[i] = __builtin_nontemporal_load((const GAS f32x4*)((W_) + (size_t)((k0_) + (F8 ? 32 * (i >> 2) + 4 * kr + (i & 3) : 8 * (i >> 1) + 2 * kr + (i & 1))) * (ldw_) + (n0_) + 4 * n4)); } while (0)
#define CVT_STORE(V_, dst_, ldd_, k0_, n0_, mode_) do { LAS unsigned* s32 = (LAS unsigned*)scr; \
            if constexpr (F8) { \
            _Pragma("unroll") for (int j = 0; j < 4; ++j) { LAS unsigned* s = s32 + (4 * n4) * 33 + 8 * j + kr;     \
                s[0] = pk_fp8x4(V_[4 * j].x * WSCALE, V_[4 * j + 1].x * WSCALE, V_[4 * j + 2].x * WSCALE, V_[4 * j + 3].x * WSCALE); s[33] = pk_fp8x4(V_[4 * j].y * WSCALE, V_[4 * j + 1].y * WSCALE, V_[4 * j + 2].y * WSCALE, V_[4 * j + 3].y * WSCALE); \
                s[66] = pk_fp8x4(V_[4 * j].z * WSCALE, V_[4 * j + 1].z * WSCALE, V_[4 * j + 2].z * WSCALE, V_[4 * j + 3].z * WSCALE); s[99] = pk_fp8x4(V_[4 * j].w * WSCALE, V_[4 * j + 1].w * WSCALE, V_[4 * j + 2].w * WSCALE, V_[4 * j + 3].w * WSCALE); } \
            LDS_WAIT(); asm volatile("" ::: "memory"); \
            _Pragma("unroll") for (int j = 0; j < 4; ++j) { const int n = (n0_) + (lane >> 3) + 8 * j; const LAS unsigned* s = s32 + ((lane >> 3) + 8 * j) * 33 + 4 * (lane & 7); \
                int orow = n; if ((mode_) == 1) { const int grp = n >> 10; if (grp == 3 || grp == 4) { const int dd = n & 127; orow = (n & ~127) + 2 * (dd & 63) + (dd >> 6); } } \
                else if ((mode_) >= 2) orow = ((n >> 7) << 8) + (n & 127) + ((mode_) == 3 ? 128 : 0); \
                u32x4 o; o.x = s[0]; o.y = s[1]; o.z = s[2]; o.w = s[3]; \
                __builtin_nontemporal_store(o, (GAS u32x4*)((unsigned char*)(dst_) + (size_t)orow * (ldd_) + (k0_) + 16 * (lane & 7))); } \
            } else { \
            _Pragma("unroll") for (int j = 0; j < 8; ++j) { LAS unsigned* s = s32 + (4 * n4) * 33 + 4 * j + kr; \
                s[0] = cvtpk(V_[2 * j].x, V_[2 * j + 1].x); s[33] = cvtpk(V_[2 * j].y, V_[2 * j + 1].y); s[66] = cvtpk(V_[2 * j].z, V_[2 * j + 1].z); s[99] = cvtpk(V_[2 * j].w, V_[2 * j + 1].w); } \
            LDS_WAIT(); asm volatile("" ::: "memory"); \
            _Pragma("unroll") for (int j = 0; j < 8; ++j) { const int n = (n0_) + ns + 8 * j; const LAS unsigned* s = s32 + (ns + 8 * j) * 33 + 4 * kg; \
                int orow = n; if ((mode_) == 1) { const int grp = n >> 10; if (grp == 3 || grp == 4) { const int dd = n & 127; orow = (n & ~127) + 2 * (dd & 63) + (dd >> 6); } } \
                else if ((mode_) >= 2) orow = ((n >> 7) << 8) + (n & 127) + ((mode_) == 3 ? 128 : 0); \
                u32x4 o; o.x = s[0]; o.y = s[1]; o.z = s[2]; o.w = s[3]; \
                __builtin_nontemporal_store(o, (GAS u32x4*)((dst_) + (size_t)orow * (ldd_) + (k0_) + 8 * kg)); } \
            } \
            LDS_WAIT(); asm volatile("" ::: "memory"); } while (0)
        f32x4 va[16], vb[16];
#define CVT_L(V_, it_) do { const float* W_ = nullptr; bf16* ds_ = nullptr; int lw_ = 0, ld_ = 0, k_ = 0, n_ = 0, mo_ = 0; CVT_DEC(it_, W_, ds_, lw_, ld_, k_, n_, mo_); (void)ds_; (void)ld_; (void)mo_; CVT_LOAD(V_, W_, lw_, k_, n_); } while (0)
#define CVT_S(V_, it_) do { const float* W_ = nullptr; bf16* ds_ = nullptr; int lw_ = 0, ld_ = 0, k_ = 0, n_ = 0, mo_ = 0; CVT_DEC(it_, W_, ds_, lw_, ld_, k_, n_, mo_); (void)W_; (void)lw_; CVT_STORE(V_, ds_, ld_, k_, n_, mo_); } while (0)
        f32x4 vc[16];
        int it = lo + gw;
        if (it < NIT) { CVT_L(va, it); if (it + NGW < NIT) CVT_L(vb, it + NGW);
            for (;;) {
                if (it + 2 * NGW < NIT) CVT_L(vc, it + 2 * NGW);
                CVT_S(va, it); it += NGW; if (it >= NIT) break;
                if (it + 2 * NGW < NIT) CVT_L(va, it + 2 * NGW);
                CVT_S(vb, it); it += NGW; if (it >= NIT) break;
                if (it + 2 * NGW < NIT) CVT_L(vb, it + 2 * NGW);
                CVT_S(vc, it); it += NGW; if (it >= NIT) break;
            }
        }
#undef CVT_L
#undef CVT_S
#undef CVT_DEC
#undef CVT_PTR
#undef CVT_LOAD
#undef CVT_STORE
    }
}

__device__ __forceinline__ void p0_prologue(const Args& a, LAS unsigned char* lds, const int g_wv) {
    const int tid = TIDX, lane = tid & 63, wave = g_wv, G = gridDim.x, bx = blockIdx.x;
    unsigned char* ws = a.ws;
    float* modv = (float*)(ws + WS_MOD);
    {
        LAS float* cs = (LAS float*)lds;
        LAS float* red = (LAS float*)(lds + 32768);
        for (int i = tid; i < 4 * D; i += NTHR) cs[i] = silu_f(a.in[I_C][i]);
        __syncthreads();
        for (int it = bx; it < 256; it += G) {
            const float* W; int ldw, col; const float* bias;
            if (it < 192) { W = a.in[I_WADA]; ldw = 6 * D; col = it * 64; bias = a.in[I_BADA]; }
            else { W = a.in[I_WAF]; ldw = 2 * D; col = (it - 192) * 64; bias = a.in[I_BAF]; }
            float a0 = 0.f, a1 = 0.f, a2 = 0.f, a3 = 0.f;
            const int kbeg = wave * 256;
#pragma unroll 4
            for (int k4 = 0; k4 < 64; ++k4) {
                const int k = kbeg + 4 * k4;
                float wv[4];
#pragma unroll
                for (int c = 0; c < 4; ++c) wv[c] = W[(size_t)(k + c) * ldw + col + lane];
                const f32x4 c0 = *(const LAS f32x4*)(cs + k), c1 = *(const LAS f32x4*)(cs + D + k), c2 = *(const LAS f32x4*)(cs + 2 * D + k), c3 = *(const LAS f32x4*)(cs + 3 * D + k);
                a0 += c0.x * wv[0] + c0.y * wv[1] + c0.z * wv[2] + c0.w * wv[3];
                a1 += c1.x * wv[0] + c1.y * wv[1] + c1.z * wv[2] + c1.w * wv[3];
                a2 += c2.x * wv[0] + c2.y * wv[1] + c2.z * wv[2] + c2.w * wv[3];
                a3 += c3.x * wv[0] + c3.y * wv[1] + c3.z * wv[2] + c3.w * wv[3];
            }
            red[(wave * 4 + 0) * 64 + lane] = a0; red[(wave * 4 + 1) * 64 + lane] = a1; red[(wave * 4 + 2) * 64 + lane] = a2; red[(wave * 4 + 3) * 64 + lane] = a3;
            __syncthreads();
            if (tid < 256) { const int b = tid >> 6; float s = bias[col + lane];
#pragma unroll
                for (int w = 0; w < 8; ++w) s += red[(w * 4 + b) * 64 + lane];
                modv[b * 16384 + it * 64 + lane] = s; }
            __syncthreads();
        }
    }
    {
        float* rope = (float*)(ws + WS_ROPE);
        for (int i = bx * NTHR + tid; i < SEQ * 64; i += G * NTHR) {
            const int pos = i >> 6, f = i & 63;
            const double rev = (double)pos * (double)c_inv_freq[f] * 0.15915494309189533577;
            const float fr = (float)(rev - __builtin_rint(rev));
            f32x2 o; o.x = __builtin_amdgcn_cosf(fr); o.y = __builtin_amdgcn_sinf(fr);
            *(GAS f32x2*)(rope + 2 * (size_t)i) = o;
        }
    }
    {
        bf16* Wrh = (bf16*)(ws + WS_WR); bf16* Wrl = Wrh + NE * D;
        for (int i = bx * NTHR + tid; i < NE * (D / 8); i += G * NTHR) {
            const int ln = i & 63, nt = (i >> 6) & 3, ks = i >> 8;
            const int e = nt * 16 + (ln & 15), k0 = 32 * ks + 8 * (ln >> 4); float v[8];
#pragma unroll
            for (int j = 0; j < 8; ++j) v[j] = a.in[I_WR][(size_t)(k0 + j) * NE + e];
            u32x4 hw, lw;
#pragma unroll
            for (int j = 0; j < 4; ++j) { const unsigned hp = cvtpk(v[2 * j], v[2 * j + 1]); ((unsigned*)&hw)[j] = hp; ((unsigned*)&lw)[j] = cvtpk(v[2 * j] - bflo(hp), v[2 * j + 1] - bfhi(hp)); }
            *(GAS u32x4*)(Wrh + (size_t)i * 8) = hw; *(GAS u32x4*)(Wrl + (size_t)i * 8) = lw;
        }
    }
    cvt_run<true>(a.ws, lds, g_wv, 0, CV_EARLY);
}

template <bool F8>
__device__ __forceinline__ void norm_rows_bf16(const float* X, const float* gain, const float* modv, int off_shift, int off_scale, bf16* Hout, const int g_wv) {
    const int tid = TIDX, lane = tid & 63, wave = g_wv;
    const int gw = blockIdx.x * NWAVES + wave, NGW = gridDim.x * NWAVES;
    f32x4 A[8], B[8]; int curb = -1;
    for (int row = (int)((long)gw * T / NGW), rowe = (int)((long)(gw + 1) * T / NGW); row < rowe; ++row) {
        const int b = row >> 12;
        if (b != curb) { curb = b;
#pragma unroll
            for (int j = 0; j < 8; ++j) { const int d = 4 * lane + 256 * j; const f32x4 g = *(const GAS f32x4*)(gain + d), sc = *(const GAS f32x4*)(modv + b * 16384 + off_scale + d);
                A[j] = g * (1.0f + sc); B[j] = *(const GAS f32x4*)(modv + b * 16384 + off_shift + d); } }
        const GAS f32x4* xr = (const GAS f32x4*)(X + (size_t)row * D) + lane;
        f32x4 v[8]; float ss = 0.f;
#pragma unroll
        for (int j = 0; j < 8; ++j) { v[j] = __builtin_nontemporal_load(xr + 64 * j); ss += (v[j].x * v[j].x + v[j].y * v[j].y) + (v[j].z * v[j].z + v[j].w * v[j].w); }
        const float rstd = __builtin_amdgcn_rsqf(wave_sum(ss) * (1.0f / D) + EPS);
        if constexpr (F8) { GAS unsigned* o4 = (GAS unsigned*)((unsigned char*)Hout + (size_t)row * D) + lane;
#pragma unroll
            for (int j = 0; j < 8; ++j) { const f32x4 h = v[j] * rstd * A[j] + B[j]; o4[64 * j] = pk_fp8x4(h.x, h.y, h.z, h.w); }
        } else { GAS u32x2* o8 = (GAS u32x2*)(Hout + (size_t)row * D) + lane;
#pragma unroll
            for (int j = 0; j < 8; ++j) { const f32x4 h = v[j] * rstd * A[j] + B[j]; u32x2 w; w.x = cvtpk(h.x, h.y); w.y = cvtpk(h.z, h.w); o8[64 * j] = w; } }
    }
}

namespace pg8 {
constexpr int BM = 256, BK = 64, HALF = 128, HTB = HALF * BK * 2, STAGE_BYTES = 8 * HTB, NXCD = 8, WGM = 8;
__host__ __device__ __forceinline__ int lds_byte(int r, int c) { const int st = (r >> 4) * 2 + (c >> 5), rr = r & 15, cc = c & 31, ob = rr * 64 + cc * 2; return st * 1024 + (ob ^ (((ob >> 9) & 1) << 5)); }
__host__ __device__ __forceinline__ void stage_rc(int b, int& R, int& C) { const int st = b / 1024, sb = b % 1024, swz = sb ^ (((sb >> 9) & 1) << 5); R = (st >> 1) * 16 + swz / 64; C = (st & 1) * 32 + (swz % 64) / 2; }
__host__ __device__ __forceinline__ int perm32(int rho) { const int n = rho >> 4, i = rho & 15; return 8 * (i >> 2) + 4 * n + (i & 3); }

struct DUnit { int pm, pn; };
struct DenseOrder {
    typedef DUnit Unit;
    int nM, nN, nwg, G, c, K, i0, cnt;
    __device__ void init(int M, int N, int K_, int G_, int c_) { nM = M / BM; nN = N / BM; nwg = nM * nN; G = G_; c = c_; K = K_; i0 = 0; cnt = 1 << 30; }
    __device__ bool next(int i, DUnit& u) const {
        if (i >= cnt) return false;
        const long L = (long)(i + i0) * G + c; if (L >= nwg) return false;
        int wgid = (int)L; { const int q = nwg / NXCD, r = nwg % NXCD, xcd = wgid % NXCD, off = wgid / NXCD; wgid = (xcd < r ? xcd * (q + 1) : r * (q + 1) + (xcd - r) * q) + off; }
        const int nig = WGM * nN, gid = wgid / nig, fm = gid * WGM, gsz = (nM - fm) < WGM ? (nM - fm) : WGM;
        u.pm = fm + ((wgid % nig) % gsz); u.pn = (wgid % nig) / gsz; return true;
    }
    __device__ __forceinline__ void a_offs(const DUnit& u, int tid, unsigned (&ao)[2][2]) const {
#pragma unroll
        for (int i = 0; i < 2; ++i) { int R, C; stage_rc(tid * 16 + i * 8192, R, C);
#pragma unroll
            for (int h = 0; h < 2; ++h) ao[h][i] = (unsigned)(((u.pm * BM + h * HALF + R) * K + C) * 2); }
    }
    __device__ __forceinline__ size_t b_off(const DUnit& u) const { return (size_t)u.pn * BM * K * 2; }
    static constexpr bool LANE_CONST = true;
    __device__ __forceinline__ unsigned a_base(const DUnit& u) const { return (unsigned)u.pm * (unsigned)(BM * K * 2); }
    __device__ __forceinline__ void a_lane(int tid, unsigned (&vo)[2]) const {
#pragma unroll
        for (int i = 0; i < 2; ++i) { int R, C; stage_rc(tid * 16 + i * 8192, R, C); vo[i] = (unsigned)((R * K + C) * 2); }
    }
};

typedef int v4i_t __attribute__((ext_vector_type(4)));
template <bool F8> struct FragT { struct T { bf16x8 kh[2]; }; };
template <> struct FragT<true> { struct T { v8i_t v; }; };
template <class Sched, class Epi, bool ALIGN_EPI, bool SP2, int PROBE = 0>
__device__ __forceinline__ void gemm_phase(LAS unsigned char* lds, const char* gA, const char* gB, const int K, const Sched& S, const Epi& E, const int g_wv) {
    static_assert(SP2, "only the two-phase-per-half schedule is kept");
    const int tid = TIDX, wid = g_wv, lane = tid & 63, wr = wid >> 2, wc = wid & 3, fr = lane & 15, fq = lane >> 4;
    const int nt = K / BK;
    constexpr bool LEAN = Epi::FP8, LANEC = LEAN && Sched::LANE_CONST, STASH = LEAN && !Sched::LANE_CONST;
    unsigned voffB[2];
#pragma unroll
    for (int i = 0; i < 2; ++i) { int R, C; stage_rc(tid * 16 + i * 8192, R, C);
        const int Rb = (Epi::PERM == 1) ? ((R & ~31) + perm32(R & 31)) : (Epi::PERM == 3) ? (64 * (R >> 5) + 16 * ((R >> 2) & 3) + 4 * ((R >> 4) & 1) + (R & 3)) : R;
        voffB[i] = (unsigned)(Rb * K + C) * 2u; }
    const size_t hstepB = (Epi::PERM == 3) ? (size_t)8 * K * 2 : (size_t)HALF * K * 2;
    const size_t kstep = (size_t)(BK * 2);
    const size_t hstep = (size_t)HALF * K * 2;
    const unsigned ldsw = (unsigned)wid * 1024u;
    const int aoff = lds_byte(wr * 64 + fr, fq * 8), boff = lds_byte(wc * 32 + fr, fq * 8);
#define PG8_SA(b, h) (((b) * 2 + (h)) * HTB)
#define PG8_SB(b, h) ((4 + (b) * 2 + (h)) * HTB)
#define PG8_STAGE_B(bufoff, gbase, h) do { const char* _bb = (const char*)(gbase) + (h) * hstepB; unsigned _lb = ldsw; asm volatile("" : "+s"(_bb), "+s"(_lb)); _Pragma("unroll") for (int _i = 0; _i < 2; ++_i) { \
        unsigned _o = voffB[_i]; asm volatile("" : "+v"(_o)); \
        __builtin_amdgcn_global_load_lds((const unsigned*)(_bb + _o), (LAS unsigned*)(lds + (bufoff) + _lb + _i * 8192), 16, 0, 0); } } while (0)
#define PG8_STAGE_A(bufoff, kb, AO, ABASE, h) do { const char* _ab = gA + (size_t)(kb) + (LANEC ? (ABASE) + (h) * hstep : (size_t)0); unsigned _lb = ldsw; asm volatile("" : "+s"(_ab), "+s"(_lb)); _Pragma("unroll") for (int _i = 0; _i < 2; ++_i) { \
        unsigned _o = LANEC ? voffA[_i] : (AO)[h][_i]; asm volatile("" : "+v"(_o)); \
        __builtin_amdgcn_global_load_lds((const unsigned*)(_ab + _o), (LAS unsigned*)(lds + (bufoff) + _lb + _i * 8192), 16, 0, 0); } } while (0)
#define PG8_LDA(dst, b, h) do { if constexpr (PROBE != 2) _Pragma("unroll") for (int m = 0; m < 4; ++m) { if constexpr (Epi::FP8) { { const v4i_t _lo = *(const LAS v4i_t*)(lds + PG8_SA(b, h) + aoff + m * 2048), _hi = *(const LAS v4i_t*)(lds + PG8_SA(b, h) + aoff + m * 2048 + 1024); dst[m].v = __builtin_shufflevector(_lo, _hi, 0, 1, 2, 3, 4, 5, 6, 7); } } \
        else { _Pragma("unroll") for (int k = 0; k < 2; ++k) dst[m].kh[k] = *(const LAS bf16x8*)(lds + PG8_SA(b, h) + aoff + m * 2048 + k * 1024); } } } while (0)
#define PG8_LDB(dst, b, h) do { if constexpr (PROBE != 2) _Pragma("unroll") for (int n = 0; n < 2; ++n) { if constexpr (Epi::FP8) { { const v4i_t _lo = *(const LAS v4i_t*)(lds + PG8_SB(b, h) + boff + n * 2048), _hi = *(const LAS v4i_t*)(lds + PG8_SB(b, h) + boff + n * 2048 + 1024); dst[n].v = __builtin_shufflevector(_lo, _hi, 0, 1, 2, 3, 4, 5, 6, 7); } } \
        else { _Pragma("unroll") for (int k = 0; k < 2; ++k) dst[n].kh[k] = *(const LAS bf16x8*)(lds + PG8_SB(b, h) + boff + n * 2048 + k * 1024); } } } while (0)
#define PG8_MMA(ai, bj, At, Bt) do { __builtin_amdgcn_s_setprio(1); if constexpr (PROBE != 1) _Pragma("unroll") for (int m = 0; m < 4; ++m) _Pragma("unroll") for (int n = 0; n < 2; ++n) { \
        if constexpr (Epi::FP8) acc[ai][bj][m][n] = __builtin_amdgcn_mfma_scale_f32_16x16x128_f8f6f4(Bt[n].v, At[m].v, acc[ai][bj][m][n], 0, 0, 0, 0, 0, 0); \
        else { _Pragma("unroll") for (int k = 0; k < 2; ++k) acc[ai][bj][m][n] = __builtin_amdgcn_mfma_f32_16x16x32_bf16(Bt[n].kh[k], At[m].kh[k], acc[ai][bj][m][n], 0, 0, 0); } } \
        _Pragma("unroll") for (int m = 0; m < 4; ++m) asm volatile("" : "+v"(acc[ai][bj][m][0]), "+v"(acc[ai][bj][m][1]));     \
        __builtin_amdgcn_s_setprio(0); } while (0)
#define PG8_WAIT_V(n) asm volatile("s_waitcnt vmcnt(" #n ")" ::: "memory")
#define PG8_WAIT_L(n) asm volatile("s_waitcnt lgkmcnt(" #n ")" ::: "memory")
#define PG8_BAR __builtin_amdgcn_s_barrier()
#define PG8_SCHED __builtin_amdgcn_sched_barrier(0)
#define PG8_STEP(KK1, KK2, KK3, PB2, PB3, AO2, AB2, HOOK2) do { \
            PG8_LDB(B0, 0, 0); PG8_LDB(B1, 0, 1); PG8_SCHED; PG8_LDA(At, 0, 0); PG8_STAGE_A(PG8_SA(1, 1), KK1, aoC, baseC, 1); \
            PG8_WAIT_V(8); PG8_WAIT_L(0); PG8_BAR; PG8_MMA(0, 0, At, B0); PG8_MMA(0, 1, At, B1); PG8_BAR; PG8_SCHED; \
            HOOK2; PG8_LDA(At, 0, 1); PG8_STAGE_B(PG8_SB(0, 0), PB2, 0); PG8_STAGE_B(PG8_SB(0, 1), PB2, 1); PG8_STAGE_A(PG8_SA(0, 0), KK2, AO2, AB2, 0); \
            PG8_WAIT_V(8); PG8_WAIT_L(0); PG8_BAR; PG8_MMA(1, 0, At, B0); PG8_MMA(1, 1, At, B1); PG8_BAR; PG8_SCHED; \
            PG8_LDB(B0, 1, 0); PG8_LDB(B1, 1, 1); PG8_SCHED; PG8_LDA(At, 1, 0); PG8_STAGE_A(PG8_SA(0, 1), KK2, AO2, AB2, 1); \
            PG8_WAIT_V(8); PG8_WAIT_L(0); PG8_BAR; PG8_MMA(0, 0, At, B0); PG8_MMA(0, 1, At, B1); PG8_BAR; PG8_SCHED; \
            PG8_LDA(At, 1, 1); PG8_STAGE_B(PG8_SB(1, 0), PB3, 0); PG8_STAGE_B(PG8_SB(1, 1), PB3, 1); PG8_STAGE_A(PG8_SA(1, 0), KK3, AO2, AB2, 0); \
            PG8_WAIT_V(8); PG8_WAIT_L(0); PG8_BAR; PG8_MMA(1, 0, At, B0); PG8_MMA(1, 1, At, B1); PG8_BAR; PG8_SCHED; } while (0)
    typename Sched::Unit cur, nxt; int ui = 0;
    if (!S.next(0, cur)) return;
    f32x4 acc[2][2][4][2];
#pragma unroll
    for (int a = 0; a < 2; ++a)
#pragma unroll
        for (int b = 0; b < 2; ++b)
#pragma unroll
            for (int m = 0; m < 4; ++m)
#pragma unroll
                for (int n = 0; n < 2; ++n) acc[a][b][m][n] = (f32x4){0.f, 0.f, 0.f, 0.f};
    typedef typename FragT<Epi::FP8>::T frag_t;
    frag_t At[4], B0[2], B1[2];
    unsigned aoC[2][2] = {{0u, 0u}, {0u, 0u}}, voffA[2] = {0u, 0u};
    unsigned baseC = 0, baseN = 0;
    if constexpr (LANEC) { S.a_lane(tid, voffA); baseC = S.a_base(cur); } else S.a_offs(cur, tid, aoC);
    const char* cB = gB + S.b_off(cur);
    PG8_STAGE_B(PG8_SB(0, 0), cB, 0); PG8_STAGE_B(PG8_SB(0, 1), cB, 1); PG8_STAGE_A(PG8_SA(0, 0), 0, aoC, baseC, 0); PG8_STAGE_A(PG8_SA(0, 1), 0, aoC, baseC, 1);
    if (wr == 1) PG8_BAR;
    PG8_WAIT_V(2); PG8_BAR;
    PG8_STAGE_B(PG8_SB(1, 0), cB + kstep, 0); PG8_STAGE_A(PG8_SA(1, 0), kstep, aoC, baseC, 0); PG8_STAGE_B(PG8_SB(1, 1), cB + kstep, 1);
    PG8_WAIT_V(6); PG8_BAR;
    for (;;) {
        const bool has_next = S.next(ui + 1, nxt);
        const char* nB = cB;
        unsigned aoN[2][2];
#pragma unroll
        for (int h = 0; h < 2; ++h)
#pragma unroll
            for (int i = 0; i < 2; ++i) aoN[h][i] = aoC[h][i];
        baseN = baseC;
        if (has_next) { nB = gB + S.b_off(nxt); if constexpr (LANEC) baseN = S.a_base(nxt); else S.a_offs(nxt, LEAN ? TIDX : tid, aoN); }
        if constexpr (STASH) *((LAS u32x4*)(lds + STASH_OFF) + TIDX) = (u32x4){aoN[0][0], aoN[0][1], aoN[1][0], aoN[1][1]};
#pragma unroll 1
        for (int t = 0; t < nt; t += 2) {
            const bool last = (t == nt - 2);
            const size_t k1 = (size_t)(t + 1) * kstep;
            const size_t k2 = last ? (size_t)0 : (size_t)(t + 2) * kstep, k3 = k2 + kstep;
            const char* b2 = last ? nB : cB + (size_t)(t + 2) * kstep; const char* b3 = b2 + kstep;
            const unsigned base2 = last ? baseN : baseC;
            unsigned ao2[2][2];
            if constexpr (STASH) {
                const u32x4 sv = *((const LAS u32x4*)(lds + STASH_OFF) + TIDX);
                PG8_STEP(k1, k2, k3, b2, b3, ao2, base2, (ao2[0][0] = last ? sv.x : aoC[0][0], ao2[0][1] = last ? sv.y : aoC[0][1], ao2[1][0] = last ? sv.z : aoC[1][0], ao2[1][1] = last ? sv.w : aoC[1][1]));
            } else {
#pragma unroll
                for (int h = 0; h < 2; ++h)
#pragma unroll
                    for (int i = 0; i < 2; ++i) ao2[h][i] = last ? aoN[h][i] : aoC[h][i];
                PG8_STEP(k1, k2, k3, b2, b3, ao2, base2, (void)0);
            }
        }
        if constexpr (STASH) { const u32x4 sv = *((const LAS u32x4*)(lds + STASH_OFF) + TIDX); aoC[0][0] = sv.x; aoC[0][1] = sv.y; aoC[1][0] = sv.z; aoC[1][1] = sv.w; }
        else {
#pragma unroll
            for (int h = 0; h < 2; ++h)
#pragma unroll
                for (int i = 0; i < 2; ++i) aoC[h][i] = aoN[h][i];
        }
        if constexpr (ALIGN_EPI) { if (wr == 0) PG8_BAR; }
        if constexpr (LEAN) { const int le = lane_now(); E(acc, cur, wr, wc, le & 15, le >> 4); }
        else E(acc, cur, wr, wc, fr, fq);
        if (!has_next) break;
#pragma unroll
        for (int a = 0; a < 2; ++a)
#pragma unroll
            for (int b = 0; b < 2; ++b)
#pragma unroll
                for (int m = 0; m < 4; ++m)
#pragma unroll
                    for (int n = 0; n < 2; ++n) acc[a][b][m][n] = (f32x4){0.f, 0.f, 0.f, 0.f};
        cur = nxt; cB = nB; baseC = baseN; ++ui;
        if constexpr (ALIGN_EPI) { if (wr == 1) PG8_BAR; }
    }
    PG8_WAIT_V(0);
    if constexpr (!ALIGN_EPI) { if (wr == 0) PG8_BAR; }
    PG8_BAR;
#undef PG8_SA
#undef PG8_SB
#undef PG8_STAGE_A
#undef PG8_STAGE_B
#undef PG8_LDA
#undef PG8_LDB
#undef PG8_MMA
#undef PG8_WAIT_V
#undef PG8_WAIT_L
#undef PG8_BAR
#undef PG8_SCHED
#undef PG8_STEP
}
}

struct EpiQKV {
    static constexpr int PERM = 1; static constexpr bool FP8 = true;
    bf16* U; const float* rope; int nostore;
    __device__ __forceinline__ void operator()(const f32x4 (&acc)[2][2][4][2], const pg8::DUnit& u, int wr, int wc, int fr, int fq) const {
        const int grp = u.pn >> 2;
        const int row0 = u.pm * 256 + wr * 64 + fr, col0 = u.pn * 256 + wc * 32 + 8 * fq;
        const float sc = ((grp == 0) ? (RSQ_HD * LOG2E) : ((grp == 4) ? RSQ_HD : 1.0f)) * (1.0f / WSCALE);
        const bool rot = (grp == 3) || (grp == 4);
        f32x4 cc[2][4][2];
#pragma unroll
        for (int ai = 0; ai < 2; ++ai)
#pragma unroll
            for (int m = 0; m < 4; ++m) { const int row = row0 + ai * 128 + m * 16; cc[ai][m][0] = (f32x4){1.f, 0.f, 1.f, 0.f}; cc[ai][m][1] = cc[ai][m][0];
                if (rot) { const float* rp = rope + ((size_t)(row & (SEQ - 1)) * 64 + 16 * wc + 4 * fq) * 2; cc[ai][m][0] = *(const GAS f32x4*)rp; cc[ai][m][1] = *(const GAS f32x4*)(rp + 4); } }
#pragma unroll
        for (int ai = 0; ai < 2; ++ai)
#pragma unroll
            for (int m = 0; m < 4; ++m) { const int row = row0 + ai * 128 + m * 16; bf16* rowp = U + (size_t)row * INC + col0;
                const f32x4 c0 = cc[ai][m][0], c1 = cc[ai][m][1];
#pragma unroll
                for (int bj = 0; bj < 2; ++bj) { f32x4 v0 = acc[ai][bj][m][0], v1 = acc[ai][bj][m][1];
                    if (rot) {
                        const f32x4 a = v0, b = v1;
                        v0.x = a.x * c0.x - a.y * c0.y; v0.y = a.x * c0.y + a.y * c0.x; v0.z = a.z * c0.z - a.w * c0.w; v0.w = a.z * c0.w + a.w * c0.z;
                        v1.x = b.x * c1.x - b.y * c1.y; v1.y = b.x * c1.y + b.y * c1.x; v1.z = b.z * c1.z - b.w * c1.w; v1.w = b.z * c1.w + b.w * c1.z;
                    }
                    v0 = v0 * sc; v1 = v1 * sc;
                    u32x4 w; w.x = cvtpk(v0.x, v0.y); w.y = cvtpk(v0.z, v0.w); w.z = cvtpk(v1.x, v1.y); w.w = cvtpk(v1.z, v1.w);
                    if (!nostore) *(GAS u32x4*)(rowp + bj * 128) = w; else asm volatile("" :: "v"(w)); } }
    }
};
struct EpiResid {
    static constexpr int PERM = 1; static constexpr bool FP8 = true;
    const float* X; bf16* X1; const float* modv;
    __device__ __forceinline__ void operator()(const f32x4 (&acc)[2][2][4][2], const pg8::DUnit& u, int wr, int wc, int fr, int fq) const {
        const int row0 = u.pm * 256 + wr * 64 + fr, col0 = u.pn * 256 + wc * 32 + 8 * fq, b = u.pm >> 4;
        f32x4 gv[2][2];
#pragma unroll
        for (int bj = 0; bj < 2; ++bj)
#pragma unroll
            for (int n = 0; n < 2; ++n) gv[bj][n] = *(const GAS f32x4*)(modv + b * 16384 + 4096 + col0 + bj * 128 + n * 4) * (1.0f / WSCALE);
#pragma unroll
        for (int ai = 0; ai < 2; ++ai) {
            f32x4 xv[4][2][2];
#pragma unroll
            for (int m = 0; m < 4; ++m) { const size_t off = (size_t)(row0 + ai * 128 + m * 16) * D + col0;
#pragma unroll
                for (int bj = 0; bj < 2; ++bj)
#pragma unroll
                    for (int n = 0; n < 2; ++n) xv[m][bj][n] = *(const GAS f32x4*)(X + off + bj * 128 + n * 4); }
#pragma unroll
            for (int m = 0; m < 4; ++m) { const size_t off = (size_t)(row0 + ai * 128 + m * 16) * D + col0;
#pragma unroll
                for (int bj = 0; bj < 2; ++bj) { const f32x4 r0 = xv[m][bj][0] + gv[bj][0] * acc[ai][bj][m][0], r1 = xv[m][bj][1] + gv[bj][1] * acc[ai][bj][m][1];
                    u32x4 w; w.x = cvtpk(r0.x, r0.y); w.y = cvtpk(r0.z, r0.w); w.z = cvtpk(r1.x, r1.y); w.w = cvtpk(r1.z, r1.w);
                    *(GAS u32x4*)(X1 + off + bj * 128) = w; } }
        }
    }
};

namespace mix {
constexpr int SHM = 16384;
#define KSWZ(row, colB) ((row) * 256 + ((colB) ^ (((row) & 7) << 4)))
__device__ __forceinline__ int v_st(int k, int c) { const int kk = (k & ~0xC) | ((k & 4) << 1) | ((k & 8) >> 1); return ((kk >> 3) * 4 + (c >> 5)) * 512 + ((kk & 7) * 32 + (c & 31)) * 2; }
__device__ __forceinline__ int v_rd_base(int lane) { return ((lane & 3) << 3) | (((lane >> 2) & 3) << 6) | (((lane >> 4) & 1) << 5) | (((lane >> 5) & 1) << 8); }
__device__ __forceinline__ int crow(int r, int hi) { return (r & 3) + 8 * (r >> 2) + 4 * hi; }
__device__ __forceinline__ int pinv(int k) { return ((k & 8) << 1) | ((k & 4) << 1) | ((k & 16) >> 2) | (k & 3); }
#define TRRD(dst, base, off) dst = __builtin_amdgcn_ds_read_tr16_b64_v4i16((LAS s16x4*)((LAS unsigned char*)(uintptr_t)(unsigned)(base) + (off)))
#define PK4(P, B_, OUT) do { unsigned a0 = cvtpk(P[B_+0], P[B_+1]), a1 = cvtpk(P[B_+2], P[B_+3]);                          \
        unsigned b0 = cvtpk(P[B_+4], P[B_+5]), b1 = cvtpk(P[B_+6], P[B_+7]);                                             \
        auto r0 = __builtin_amdgcn_permlane32_swap(a0, b0, false, false); auto r1 = __builtin_amdgcn_permlane32_swap(a1, b1, false, false); \
        u32x4 w = {r0[0], r1[0], r0[1], r1[1]}; OUT = *reinterpret_cast<bf16x8*>(&w); } while (0)
__device__ __forceinline__ bf16x8 cat8(s16x4 l, s16x4 h) { return (bf16x8){l[0], l[1], l[2], l[3], h[0], h[1], h[2], h[3]}; }

template <int KB>
__device__ __forceinline__ void qkt(f32x16& p0, f32x16& p1, const char* K_lds, int r32, int hi, const bf16x8* qr) {
    p0 = f32x16{}; p1 = f32x16{};
    const char* kb[4];
#pragma unroll
    for (int dd = 0; dd < 4; ++dd) kb[dd] = K_lds + KB * SHM + KSWZ(r32, (dd * 16 + hi * 8) * 2);
#pragma unroll
    for (int d0 = 0; d0 < 8; ++d0) { const char* a = kb[d0 & 3] + (d0 >> 2) * 128;
        bf16x8 b0 = *reinterpret_cast<const bf16x8*>(a);
        bf16x8 b1 = *reinterpret_cast<const bf16x8*>(a + 32 * 256);
        p0 = __builtin_amdgcn_mfma_f32_32x32x16_bf16(b0, qr[d0], p0, 0, 0, 0);
        p1 = __builtin_amdgcn_mfma_f32_32x32x16_bf16(b1, qr[d0], p1, 0, 0, 0); }
}
template <int VB>
__device__ __forceinline__ void pv_tile(f32x16* o, int vb0, bf16x8 pa0, bf16x8 pa1, bf16x8 pa2, bf16x8 pa3) {
#define PV_D0(d0) do { s16x4 l0, l1, l2, l3, h0, h1, h2, h3; constexpr int b_ = VB * SHM + (d0) * 512; \
        TRRD(l0, vb0, b_); TRRD(h0, vb0, b_ + 2048); TRRD(l1, vb0, b_ + 4096); TRRD(h1, vb0, b_ + 6144); TRRD(l2, vb0, b_ + 8192); TRRD(h2, vb0, b_ + 10240); TRRD(l3, vb0, b_ + 12288); TRRD(h3, vb0, b_ + 14336); \
        \
        o[d0] = __builtin_amdgcn_mfma_f32_32x32x16_bf16(pa0, cat8(l0, h0), o[d0], 0, 0, 0);   \
        o[d0] = __builtin_amdgcn_mfma_f32_32x32x16_bf16(pa1, cat8(l1, h1), o[d0], 0, 0, 0);   \
        o[d0] = __builtin_amdgcn_mfma_f32_32x32x16_bf16(pa2, cat8(l2, h2), o[d0], 0, 0, 0);   \
        o[d0] = __builtin_amdgcn_mfma_f32_32x32x16_bf16(pa3, cat8(l3, h3), o[d0], 0, 0, 0); } while (0)
    PV_D0(0); PV_D0(1); PV_D0(2); PV_D0(3);
#undef PV_D0
}
__device__ __forceinline__ void sb_weights(f32x16& p0, f32x16& p1, float& Rrun, int hi) {
    float T1 = 1.f, T0 = 1.f;
#pragma unroll
    for (int r = 0; r < 16; ++r) { const float e = fast_exp2(fminf(p1[r], 80.f)); const float om = fast_rcp(1.0f + e); p1[r] = e * om; T1 *= om; }
#pragma unroll
    for (int r = 0; r < 16; ++r) { const float e = fast_exp2(fminf(p0[r], 80.f)); const float om = fast_rcp(1.0f + e); p0[r] = e * om; T0 *= om; }
    const auto s1 = __builtin_amdgcn_permlane32_swap(__float_as_uint(T1), __float_as_uint(T1), false, false);
    const auto s0 = __builtin_amdgcn_permlane32_swap(__float_as_uint(T0), __float_as_uint(T0), false, false);
    const float T1p = __uint_as_float(hi ? s1[0] : s1[1]), T0p = __uint_as_float(hi ? s0[0] : s0[1]);
    const float t11 = T1 * T1p;
    float run = hi ? Rrun : Rrun * T1p;
#pragma unroll
    for (int r = 15; r >= 0; --r) { const float w = p1[r] * run; run -= w; p1[r] = w; }
    run = Rrun * t11 * (hi ? 1.0f : T0p);
#pragma unroll
    for (int r = 15; r >= 0; --r) { const float w = p0[r] * run; run -= w; p0[r] = w; }
    Rrun = Rrun * t11 * (T0 * T0p);
}
__device__ __forceinline__ void store_o32(const f32x16* o, unsigned char* Ow, int ldo, int r32, int hi) {
    const unsigned lo = (unsigned)(4 * hi * ldo + r32);
#pragma unroll
    for (int r = 0; r < 16; ++r) { unsigned char* rowp = Ow + (size_t)((r & 3) + 8 * (r >> 2)) * ldo;
#pragma unroll
        for (int d0 = 0; d0 < 4; ++d0) { const float v = o[d0][r]; const float v1 = __shfl_xor(v, 1), v2 = __shfl_xor(v, 2), v3 = __shfl_xor(v, 3);
            if ((r32 & 3) == 0) *(GAS unsigned*)(rowp + lo + d0 * 32) = pk_fp8x4(v, v1, v2, v3); } }
}

__device__ __forceinline__ void sb_part1(f32x16& p0, float& T0) {
    float t = 1.f;
#pragma unroll
    for (int r = 0; r < 16; ++r) { const float e = fast_exp2(fminf(p0[r], 80.f)); const float om = fast_rcp(1.0f + e); p0[r] = e * om; t *= om; }
    T0 = t;
}
__device__ __forceinline__ void sb_part2(f32x16& p0, f32x16& p1, float T0, float& Rrun, int hi, bf16x8& pa0, bf16x8& pa1, bf16x8& pa2, bf16x8& pa3) {
    float T1 = 1.f;
#pragma unroll
    for (int r = 0; r < 16; ++r) { const float e = fast_exp2(fminf(p1[r], 80.f)); const float om = fast_rcp(1.0f + e); p1[r] = e * om; T1 *= om; }
    const auto s1 = __builtin_amdgcn_permlane32_swap(__float_as_uint(T1), __float_as_uint(T1), false, false);
    const auto s0 = __builtin_amdgcn_permlane32_swap(__float_as_uint(T0), __float_as_uint(T0), false, false);
    const float T1p = __uint_as_float(hi ? s1[0] : s1[1]), T0p = __uint_as_float(hi ? s0[0] : s0[1]);
    const float t11 = T1 * T1p;
    float run = hi ? Rrun : Rrun * T1p;
#pragma unroll
    for (int r = 15; r >= 0; --r) { const float w = p1[r] * run; run -= w; p1[r] = w; }
    run = Rrun * t11 * (hi ? 1.0f : T0p);
#pragma unroll
    for (int r = 15; r >= 0; --r) { const float w = p0[r] * run; run -= w; p0[r] = w; }
    Rrun = Rrun * t11 * (T0 * T0p);
    PK4(p0, 0, pa0); PK4(p0, 8, pa1); PK4(p1, 0, pa2); PK4(p1, 8, pa3);
}
__device__ __forceinline__ void qkt_rt(f32x16& p0, f32x16& p1, const LAS unsigned char* K_lds, int kbo, int r32, int hi, const bf16x8* qr) {
    p0 = f32x16{}; p1 = f32x16{};
    const LAS unsigned char* kb[4];
#pragma unroll
    for (int dd = 0; dd < 4; ++dd) kb[dd] = K_lds + kbo + KSWZ(r32, (dd * 16 + hi * 8) * 2);
#pragma unroll
    for (int d0 = 0; d0 < 8; ++d0) { const LAS unsigned char* a = kb[d0 & 3] + (d0 >> 2) * 128;
        bf16x8 b0 = *reinterpret_cast<const LAS bf16x8*>(a);
        bf16x8 b1 = *reinterpret_cast<const LAS bf16x8*>(a + 32 * 256);
        p0 = __builtin_amdgcn_mfma_f32_32x32x16_bf16(b0, qr[d0], p0, 0, 0, 0);
        p1 = __builtin_amdgcn_mfma_f32_32x32x16_bf16(b1, qr[d0], p1, 0, 0, 0); }
}
__device__ __forceinline__ void pv_rt(f32x16* o, int vb, bf16x8 pa0, bf16x8 pa1, bf16x8 pa2, bf16x8 pa3) {
#define PV_D0(d0) do { s16x4 l0, l1, l2, l3, h0, h1, h2, h3; constexpr int b_ = (d0) * 512; \
        TRRD(l0, vb, b_); TRRD(h0, vb, b_ + 2048); TRRD(l1, vb, b_ + 4096); TRRD(h1, vb, b_ + 6144); TRRD(l2, vb, b_ + 8192); TRRD(h2, vb, b_ + 10240); TRRD(l3, vb, b_ + 12288); TRRD(h3, vb, b_ + 14336); \
        \
        o[d0] = __builtin_amdgcn_mfma_f32_32x32x16_bf16(pa0, cat8(l0, h0), o[d0], 0, 0, 0);   \
        o[d0] = __builtin_amdgcn_mfma_f32_32x32x16_bf16(pa1, cat8(l1, h1), o[d0], 0, 0, 0);   \
        o[d0] = __builtin_amdgcn_mfma_f32_32x32x16_bf16(pa2, cat8(l2, h2), o[d0], 0, 0, 0);   \
        o[d0] = __builtin_amdgcn_mfma_f32_32x32x16_bf16(pa3, cat8(l3, h3), o[d0], 0, 0, 0); } while (0)
    PV_D0(0); PV_D0(1); SBAR(); PV_D0(2); PV_D0(3);
#undef PV_D0
}
__device__ __forceinline__ int key_of_row(int i) { const int j = i & 31; return (i & 32) + ((j >> 2) & 1) * 16 + ((j >> 3) & 3) * 4 + (j & 3); }
__device__ __forceinline__ void sb_all(f32x16& p0, f32x16& p1, float& Rrun, int hi, bf16x8& pa0, bf16x8& pa1, bf16x8& pa2, bf16x8& pa3) {
    float T1 = 1.f, T0 = 1.f;
#pragma unroll
    for (int r = 0; r < 16; ++r) { const float om = fast_rcp(1.0f + fast_exp2(p1[r])); p1[r] = 1.0f - om; T1 *= om; }
#pragma unroll
    for (int r = 0; r < 16; ++r) { const float om = fast_rcp(1.0f + fast_exp2(p0[r])); p0[r] = 1.0f - om; T0 *= om; }
    const auto s1 = __builtin_amdgcn_permlane32_swap(__float_as_uint(T1), __float_as_uint(T1), false, false);
    const auto s0 = __builtin_amdgcn_permlane32_swap(__float_as_uint(T0), __float_as_uint(T0), false, false);
    const float T1p = __uint_as_float(hi ? s1[0] : s1[1]), T0p = __uint_as_float(hi ? s0[0] : s0[1]);
    const float t11 = T1 * T1p;
    float run = hi ? Rrun : Rrun * T1p;
#pragma unroll
    for (int r = 15; r >= 0; --r) { const float w = p1[r] * run; run -= w; p1[r] = w; }
    run = Rrun * t11 * (hi ? 1.0f : T0p);
#pragma unroll
    for (int r = 15; r >= 0; --r) { const float w = p0[r] * run; run -= w; p0[r] = w; }
    Rrun = Rrun * t11 * (T0 * T0p);
    PK4(p0, 0, pa0); PK4(p0, 8, pa1); PK4(p1, 0, pa2); PK4(p1, 8, pa3);
}
__device__ __forceinline__ void attn_item(const bf16* U, bf16* O, int bh, int qb, LAS unsigned char* ldsl, char* lds, const int g_wv, const int pmode) {
    const int tid = TIDX, wid = g_wv, lane = tid & 63, r32 = lane & 31, hi = lane >> 5;
    const int b = bh >> 3, h = bh & 7;
    const bf16* Qp = U + (size_t)(b * SEQ + qb * 256) * INC + h * HD;
    const bf16* Kp = U + (size_t)(b * SEQ) * INC + 1024 + h * HD;
    const bf16* Vp = U + (size_t)(b * SEQ) * INC + 2048 + h * HD;
    const LAS unsigned char* K_lds = ldsl; char* V_lds = lds + 4 * SHM;
    bf16x8 qr[8];
    { const unsigned lo_q = (unsigned)((wid * 32 + r32) * INC + hi * 8);
#pragma unroll
      for (int d0 = 0; d0 < 8; ++d0) qr[d0] = *(const GAS bf16x8*)(Qp + lo_q + d0 * 16); }
    unsigned ksrc[2], vsrc[2];
#pragma unroll
    for (int i = 0; i < 2; ++i) { const int p = 2 * wid + i;
        { const int row = 4 * p + (lane >> 4), ch = (lane & 15) ^ (row & 7); ksrc[i] = (unsigned)(key_of_row(row) * INC + ch * 8); }
        { const int S = 2 * p + (lane >> 5), kk = (S >> 2) * 8 + ((lane & 31) >> 2), c = (S & 3) * 32 + (lane & 3) * 8; const int k = (kk & ~0xC) | ((kk & 4) << 1) | ((kk & 8) >> 1);
          vsrc[i] = (unsigned)(key_of_row(k) * INC + c); } }
    const int vb0 = (int)(uintptr_t)V_lds + v_rd_base(lane);
    const LAS unsigned char* kbase[4];
#pragma unroll
    for (int dd = 0; dd < 4; ++dd) kbase[dd] = K_lds + KSWZ(r32, (dd * 16 + hi * 8) * 2);
    const int NT = 4 * (qb + 1);
    const int qlo = qb * 256 + wid * 32;
    volatile LAS unsigned* eflag = (volatile LAS unsigned*)(ldsl + LDSCTL_OFF) + 32;
    const float RTH = 8.27e-25f;
#define DMA_TILE(t_) do { const size_t ro_ = (size_t)((pmode == 1 ? 0 : (NT - 1 - (t_))) * 64) * INC; const int so_ = ((t_) & 3) * SHM + wid * 2048; \
        _Pragma("unroll") for (int i_ = 0; i_ < 2; ++i_) { \
            __builtin_amdgcn_global_load_lds((const unsigned*)(Kp + ro_ + ksrc[i_]), (LAS unsigned*)(ldsl + so_ + i_ * 1024), 16, 0, 0); \
            __builtin_amdgcn_global_load_lds((const unsigned*)(Vp + ro_ + vsrc[i_]), (LAS unsigned*)(ldsl + 4 * SHM + so_ + i_ * 1024), 16, 0, 0); } } while (0)
#define SBMASK(P0_, P1_, t_) do { const int kb_ = (NT - 1 - (t_)) * 64; if (kb_ + 63 >= qlo) { const int dq = qlo + r32 - kb_ - 16 * hi; const float NEG = -__builtin_inff(); \
        _Pragma("unroll") for (int r = 0; r < 16; ++r) { if (r >= dq) P0_[r] = NEG; if (r + 32 >= dq) P1_[r] = NEG; } } } while (0)
#define WAITV(n_) asm volatile("s_waitcnt vmcnt(" #n_ ")" ::: "memory")
#define RBAR() do { asm volatile("s_waitcnt lgkmcnt(0)" ::: "memory"); __builtin_amdgcn_s_barrier(); asm volatile("" ::: "memory"); } while (0)
#define QK2(PX0, PX1, ko_, s_) do { const LAS unsigned char* a_ = kbase[(s_) & 3] + (ko_) + ((s_) >> 2) * 128; \
        const bf16x8 b0_ = *reinterpret_cast<const LAS bf16x8*>(a_), b1_ = *reinterpret_cast<const LAS bf16x8*>(a_ + 32 * 256); \
        PX0 = __builtin_amdgcn_mfma_f32_32x32x16_bf16(b0_, qr[s_], PX0, 0, 0, 0); PX1 = __builtin_amdgcn_mfma_f32_32x32x16_bf16(b1_, qr[s_], PX1, 0, 0, 0); } while (0)
#define EB(P_, r_, T_) do { const float om_ = fast_rcp(1.0f + fast_exp2(P_[r_])); P_[r_] = 1.0f - om_; T_ *= om_; } while (0)
#define WB(P_, r_) do { float w_; asm("v_mul_f32 %0, %1, %2" : "=v"(w_) : "v"(P_[r_]), "v"(run)); asm("v_sub_f32 %0, %1, %2" : "=v"(run) : "v"(run), "v"(w_)); P_[r_] = w_; } while (0)
#define BLOCK1(PX0, PX1, PY0, PY1, T0Y, ko_) do { PX0 = f32x16{}; PX1 = f32x16{}; float T1 = 1.f, run, T1p, T0p, t11; \
        QK2(PX0, PX1, ko_, 0); EB(PY1, 0, T1); EB(PY1, 1, T1); EB(PY1, 2, T1); EB(PY1, 3, T1); EB(PY1, 4, T1); EB(PY1, 5, T1); SBAR(); \
        QK2(PX0, PX1, ko_, 1); EB(PY1, 6, T1); EB(PY1, 7, T1); EB(PY1, 8, T1); EB(PY1, 9, T1); EB(PY1, 10, T1); SBAR(); \
        QK2(PX0, PX1, ko_, 2); EB(PY1, 11, T1); EB(PY1, 12, T1); EB(PY1, 13, T1); EB(PY1, 14, T1); EB(PY1, 15, T1); \
        { const auto s1_ = __builtin_amdgcn_permlane32_swap(__float_as_uint(T1), __float_as_uint(T1), false, false); const auto s0_ = __builtin_amdgcn_permlane32_swap(__float_as_uint(T0Y), __float_as_uint(T0Y), false, false); \
          T1p = __uint_as_float(hi ? s1_[0] : s1_[1]); T0p = __uint_as_float(hi ? s0_[0] : s0_[1]); t11 = T1 * T1p; run = hi ? Rrun : Rrun * T1p; } SBAR(); \
        QK2(PX0, PX1, ko_, 3); WB(PY1, 15); WB(PY1, 14); WB(PY1, 13); WB(PY1, 12); WB(PY1, 11); WB(PY1, 10); WB(PY1, 9); WB(PY1, 8); SBAR(); \
        QK2(PX0, PX1, ko_, 4); WB(PY1, 7); WB(PY1, 6); WB(PY1, 5); WB(PY1, 4); WB(PY1, 3); WB(PY1, 2); WB(PY1, 1); WB(PY1, 0); run = Rrun * t11 * (hi ? 1.0f : T0p); SBAR(); \
        QK2(PX0, PX1, ko_, 5); WB(PY0, 15); WB(PY0, 14); WB(PY0, 13); WB(PY0, 12); WB(PY0, 11); WB(PY0, 10); WB(PY0, 9); WB(PY0, 8); SBAR(); \
        QK2(PX0, PX1, ko_, 6); WB(PY0, 7); WB(PY0, 6); WB(PY0, 5); WB(PY0, 4); WB(PY0, 3); WB(PY0, 2); WB(PY0, 1); WB(PY0, 0); Rrun = Rrun * t11 * (T0Y * T0p); SBAR(); \
        QK2(PX0, PX1, ko_, 7); PK4(PY0, 0, pa0); PK4(PY0, 8, pa1); PK4(PY1, 0, pa2); PK4(PY1, 8, pa3); SBAR(); } while (0)
#define PART1(P0_, T0_) do { float t_ = 1.f; _Pragma("unroll") for (int r = 0; r < 16; ++r) EB(P0_, r, t_); T0_ = t_; } while (0)
    DMA_TILE(0); DMA_TILE(1);
    WAITV(4); RBAR();
    float Rrun = 1.f, T0A, T0B; f32x16 o[4] = {};
    f32x16 pA0, pA1, pB0, pB1; bf16x8 pa0, pa1, pa2, pa3;
    DMA_TILE(2);
    qkt_rt(pA0, pA1, K_lds, 0, r32, hi, qr);
    SBMASK(pA0, pA1, 0); PART1(pA0, T0A);
    WAITV(4); RBAR();
#define STEP(PX0, PX1, T0X, PY0, PY1, T0Y, t_) do { \
        if ((t_) + 2 < NT) DMA_TILE((t_) + 2); SBAR(); \
        BLOCK1(PX0, PX1, PY0, PY1, T0Y, ((t_) & 3) * SHM); \
        { const bool wd_ = __all(Rrun < RTH); if (lane == 0) eflag[((t_) & 1) * 8 + wid] = wd_ ? 1u : 0u; } \
        pv_rt(o, vb0 + (((t_) - 1) & 3) * SHM, pa0, pa1, pa2, pa3); \
        SBMASK(PX0, PX1, t_); PART1(PX0, T0X); SBAR(); \
        if ((t_) + 2 < NT) WAITV(4); else WAITV(0); \
        RBAR(); \
        { unsigned s_ = 0u; _Pragma("unroll") for (int w_ = 0; w_ < 8; ++w_) s_ += eflag[((t_) & 1) * 8 + w_]; done = ((unsigned)__builtin_amdgcn_readfirstlane((int)s_) == 8u) && (pmode == 0); } } while (0)
    int t = 1, NTe = NT; bool done = false;
    for (; t + 1 < NTe; t += 2) { STEP(pB0, pB1, T0B, pA0, pA1, T0A, t); STEP(pA0, pA1, T0A, pB0, pB1, T0B, t + 1); NTe = done ? 0 : NTe; }
    STEP(pB0, pB1, T0B, pA0, pA1, T0A, t);
    sb_part2(pB0, pB1, T0B, Rrun, hi, pa0, pa1, pa2, pa3); SBAR();
    pv_rt(o, vb0 + (t & 3) * SHM, pa0, pa1, pa2, pa3);
    asm volatile("s_waitcnt vmcnt(0)" ::: "memory");
#undef STEP
#undef BLOCK1
#undef PART1
#undef QK2
#undef EB
#undef WB
#undef DMA_TILE
#undef SBMASK
#undef WAITV
#undef RBAR
    store_o32(o, (unsigned char*)O + (size_t)(b * SEQ + qb * 256 + wid * 32) * D + h * HD, D, r32, hi);
}

__device__ __forceinline__ void ret_state_stream(const bf16* U, bf16* RTg, int bh, char* lds, const int g_wv) {
    const int tid = TIDX, wid = g_wv, lane = tid & 63, r32 = lane & 31, hi = lane >> 5;
    const int dkb = wid & 3, dvh = wid >> 2;
    const int b = bh >> 3, h = bh & 7;
    const float lg = __log2f(1.0f - __builtin_ldexpf(1.0f, -5 - h));
    const bf16* Kp = U + (size_t)(b * SEQ) * INC + 4096 + h * HD;
    const bf16* Vp = U + (size_t)(b * SEQ) * INC + 5120 + h * HD;
    const int sr = tid >> 4, sc = (tid & 15) * 8;
    const unsigned lo_kv = (unsigned)(sr * INC + sc);
    const int ktb0 = (int)(uintptr_t)lds + v_rd_base(lane) + dkb * 512, vtb0 = (int)(uintptr_t)(lds + 32768) + v_rd_base(lane) + dvh * 1024;
    const int ktb1 = ktb0 + 65536, vtb1 = vtb0 + 65536;
    bf16x8 ka[4], va[4], kb[4], vb[4];
    const float cd = fast_exp2(128.0f * lg);
    f32x16 Racc[2] = {};
#define SLOADS(n_, K_, V_) do { _Pragma("unroll") for (int i = 0; i < 4; ++i) { const size_t ro = (size_t)((n_) * 128 + 32 * i) * INC; K_[i] = *(const GAS bf16x8*)(Kp + ro + lo_kv); V_[i] = *(const GAS bf16x8*)(Vp + ro + lo_kv); } } while (0)
#define SWRITES(p_, K_, V_) do { float lgw = lg; asm volatile("" : "+v"(lgw)); _Pragma("unroll") for (int i = 0; i < 4; ++i) { const int c = sr + 32 * i, tile = i >> 1, cr = c & 63; \
        const float f = fast_exp2((float)(127 - c) * lgw); const u32x4 kw = *reinterpret_cast<const u32x4*>(&K_[i]); u32x4 kd; \
        kd.x = cvtpk(bflo(kw.x) * f, bfhi(kw.x) * f); kd.y = cvtpk(bflo(kw.y) * f, bfhi(kw.y) * f); kd.z = cvtpk(bflo(kw.z) * f, bfhi(kw.z) * f); kd.w = cvtpk(bflo(kw.w) * f, bfhi(kw.w) * f); \
        *(u32x4*)(lds + (p_) * 65536 + tile * SHM + v_st(cr, sc)) = kd; \
        *(bf16x8*)(lds + (p_) * 65536 + 32768 + tile * SHM + v_st(cr, sc)) = V_[i]; } } while (0)
#define SCOMPUTE(KTB, VTB) do { _Pragma("unroll") for (int r = 0; r < 16; ++r) { Racc[0][r] *= cd; Racc[1][r] *= cd; } \
        _Pragma("unroll") for (int tl = 0; tl < 2; ++tl) _Pragma("unroll") for (int ks = 0; ks < 4; ++ks) { s16x4 al, ah, bl0, bh0, bl1, bh1; const int o_ = tl * SHM + ks * 4096; \
            TRRD(al, KTB, o_); TRRD(ah, KTB, o_ + 2048); TRRD(bl0, VTB, o_); TRRD(bh0, VTB, o_ + 2048); TRRD(bl1, VTB, o_ + 512); TRRD(bh1, VTB, o_ + 512 + 2048); \
            const bf16x8 af = cat8(al, ah); \
            Racc[0] = __builtin_amdgcn_mfma_f32_32x32x16_bf16(af, cat8(bl0, bh0), Racc[0], 0, 0, 0); \
            Racc[1] = __builtin_amdgcn_mfma_f32_32x32x16_bf16(af, cat8(bl1, bh1), Racc[1], 0, 0, 0); } } while (0)
#define SSTORE(n1_) do { bf16* rt = RTg + (size_t)(bh * 32 + (n1_)) * 16384; _Pragma("unroll") for (int t = 0; t < 2; ++t) _Pragma("unroll") for (int g = 0; g < 4; ++g) { \
        u32x2 w; w.x = cvtpk(Racc[t][4 * g], Racc[t][4 * g + 1]); w.y = cvtpk(Racc[t][4 * g + 2], Racc[t][4 * g + 3]); \
        *(GAS u32x2*)(rt + (size_t)((2 * dvh + t) * 32 + r32) * 128 + dkb * 32 + 8 * g + 4 * hi) = w; } } while (0)
    SLOADS(0, ka, va); SLOADS(1, kb, vb);
    for (int n = 0; n < 31; n += 2) {
        SWRITES(0, ka, va); SBAR();
        if (n + 2 < 31) SLOADS(n + 2, ka, va);
        __syncthreads();
        SCOMPUTE(ktb0, vtb0); SSTORE(n + 1);
        if (n + 1 < 31) {
            SWRITES(1, kb, vb); SBAR();
            if (n + 3 < 31) SLOADS(n + 3, kb, vb);
            __syncthreads();
            SCOMPUTE(ktb1, vtb1); SSTORE(n + 2);
        }
    }
    __syncthreads();
#undef SLOADS
#undef SWRITES
#undef SCOMPUTE
#undef SSTORE
}

__device__ __forceinline__ float row16_sum(float s) {
    s += __builtin_bit_cast(float, __builtin_amdgcn_update_dpp(0, __builtin_bit_cast(int, s), 0xB1, 0xf, 0xf, false));
    s += __builtin_bit_cast(float, __builtin_amdgcn_update_dpp(0, __builtin_bit_cast(int, s), 0x4E, 0xf, 0xf, false));
    s += __builtin_bit_cast(float, __builtin_amdgcn_update_dpp(0, __builtin_bit_cast(int, s), 0x124, 0xf, 0xf, false));
    s += __builtin_bit_cast(float, __builtin_amdgcn_update_dpp(0, __builtin_bit_cast(int, s), 0x128, 0xf, 0xf, false));
    return s;
}
__device__ __forceinline__ void ret_chunk_items(const bf16* U, const bf16* RTg, bf16* O, const float* gn_g, char* lds, const int g_wv) {
    const int tid = TIDX, wid = g_wv, lane = tid & 63, r32 = lane & 31, hi = lane >> 5;
    const int ib = wid & 3, dvh = wid >> 2;
    char* KS = lds; char* VT = lds + 32768; char* GT = lds + 65536; char* RT = lds + 98304; float* SSQ = (float*)(lds + 131072);
    const int sr = tid >> 4, sc = (tid & 15) * 8;
    const unsigned lo_kv = (unsigned)(sr * INC + sc), lo_q = (unsigned)((ib * 32 + r32) * INC + hi * 8), lo_r = (unsigned)(sr * 128 + sc);
    const int vtb = (int)(uintptr_t)VT + v_rd_base(lane) + dvh * 1024;
    const char* ksb[4];
#pragma unroll
    for (int dd = 0; dd < 4; ++dd) ksb[dd] = KS + KSWZ(r32, (dd * 16 + hi * 8) * 2);
    const char* rtb[4];
#pragma unroll
    for (int dd = 0; dd < 4; ++dd) rtb[dd] = RT + KSWZ(dvh * 64 + r32, (dd * 16 + hi * 8) * 2);
    bf16x8 sk[4], sv[4], sg[4], srr[4], qr[8];
    const int G = (int)gridDim.x;
#define RC_BASE(it_) const int bh_ = (it_) & 31, n_ = (it_) >> 5, b_ = bh_ >> 3, h_ = bh_ & 7; const size_t rowbase_ = (size_t)(b_ * SEQ + n_ * 128)
#define RC_LOAD_KVG(it_) do { RC_BASE(it_); const bf16* Kp = U + rowbase_ * INC + 4096 + h_ * HD; const bf16* Vp = U + rowbase_ * INC + 5120 + h_ * HD; \
        _Pragma("unroll") for (int i = 0; i < 4; ++i) { const size_t ro = (size_t)(32 * i) * INC; sk[i] = *(const GAS bf16x8*)(Kp + ro + lo_kv); sv[i] = *(const GAS bf16x8*)(Vp + ro + lo_kv); } } while (0)
#define RC_LOAD_QR(it_) do { RC_BASE(it_); const bf16* Qp = U + rowbase_ * INC + 3072 + h_ * HD; const bf16* Gp = U + rowbase_ * INC + 6144 + h_ * HD; \
        _Pragma("unroll") for (int i = 0; i < 4; ++i) sg[i] = *(const GAS bf16x8*)(Gp + (size_t)(32 * i) * INC + lo_kv); \
        _Pragma("unroll") for (int d0 = 0; d0 < 8; ++d0) qr[d0] = *(const GAS bf16x8*)(Qp + lo_q + d0 * 16); \
        if (n_ > 0) { const bf16* rt = RTg + (size_t)(bh_ * 32 + n_) * 16384; \
            _Pragma("unroll") for (int i = 0; i < 4; ++i) srr[i] = *(const GAS bf16x8*)(rt + (size_t)(32 * i) * 128 + lo_r); } } while (0)
    int it = (int)blockIdx.x;
    if (it >= 1024) return;
    RC_LOAD_KVG(it); RC_LOAD_QR(it);
    for (; it < 1024; it += G) {
        RC_BASE(it);
        const float lg = __log2f(1.0f - __builtin_ldexpf(1.0f, -5 - h_));
#pragma unroll
        for (int i = 0; i < 4; ++i) { const int c = sr + 32 * i, tile = i >> 1, cr = c & 63;
            const float fs = fast_exp2(-(float)c * lg); const u32x4 kw = *reinterpret_cast<const u32x4*>(&sk[i]); u32x4 ke;
            ke.x = cvtpk(bflo(kw.x) * fs, bfhi(kw.x) * fs); ke.y = cvtpk(bflo(kw.y) * fs, bfhi(kw.y) * fs); ke.z = cvtpk(bflo(kw.z) * fs, bfhi(kw.z) * fs); ke.w = cvtpk(bflo(kw.w) * fs, bfhi(kw.w) * fs);
            *(u32x4*)(KS + tile * SHM + KSWZ(cr, sc * 2)) = ke;
            *(bf16x8*)(VT + tile * SHM + v_st(cr, sc)) = sv[i];
            *(bf16x8*)(GT + c * 256 + sc * 2) = sg[i];
            if (n_ > 0) *(bf16x8*)(RT + KSWZ(c, sc * 2)) = srr[i]; }
        SBAR();
        if (it + G < 1024) RC_LOAD_KVG(it + G);
        const float lf = fast_exp2((float)(ib * 32 + r32) * lg);
        __syncthreads();
        f32x16 acc[2] = {};
        if (n_ > 0) {
#pragma unroll
            for (int t = 0; t < 2; ++t)
#pragma unroll
                for (int s = 0; s < 8; ++s) { const bf16x8 rfr = *(const bf16x8*)(rtb[s & 3] + t * 8192 + (s >> 2) * 128); acc[t] = __builtin_amdgcn_mfma_f32_32x32x16_bf16(qr[s], rfr, acc[t], 0, 0, 0); }
#pragma unroll
            for (int r = 0; r < 16; ++r) { const float f = fast_exp2((float)(ib * 32 + crow(r, hi) + 1) * lg); acc[0][r] *= f; acc[1][r] *= f; }
        }
#pragma unroll
        for (int jb = 0; jb < 4; ++jb) {
            if (jb <= ib) {
                f32x16 p = {};
#pragma unroll
                for (int d0 = 0; d0 < 8; ++d0) { const bf16x8 kf = *(const bf16x8*)(ksb[d0 & 3] + (jb >> 1) * SHM + (jb & 1) * 8192 + (d0 >> 2) * 128);
                    p = __builtin_amdgcn_mfma_f32_32x32x16_bf16(kf, qr[d0], p, 0, 0, 0); }
#pragma unroll
                for (int r = 0; r < 16; ++r) { const int diff = (ib - jb) * 32 + r32 - crow(r, hi); p[r] = diff >= 0 ? p[r] * lf : 0.f; }
                bf16x8 pa0, pa1; PK4(p, 0, pa0); PK4(p, 8, pa1); SBAR();
#pragma unroll
                for (int t = 0; t < 2; ++t) { s16x4 l0, h0, l1, h1; const int o_ = (jb >> 1) * SHM + t * 512 + (jb & 1) * 8192;
                    TRRD(l0, vtb, o_); TRRD(h0, vtb, o_ + 2048); TRRD(l1, vtb, o_ + 4096); TRRD(h1, vtb, o_ + 6144);
                    acc[t] = __builtin_amdgcn_mfma_f32_32x32x16_bf16(pa0, cat8(l0, h0), acc[t], 0, 0, 0);
                    acc[t] = __builtin_amdgcn_mfma_f32_32x32x16_bf16(pa1, cat8(l1, h1), acc[t], 0, 0, 0); }
            }
        }
        SBAR();
        if (it + G < 1024) RC_LOAD_QR(it + G);
        float* ssqw = SSQ + wid * 32 + 4 * hi; const float* ssqp = SSQ + (wid ^ 4) * 32 + 4 * hi;
#pragma unroll
        for (int r = 0; r < 16; ++r) { float s = row16_sum(acc[0][r] * acc[0][r] + acc[1][r] * acc[1][r]); s += __shfl_xor(s, 16);
            if (r32 == 0) ssqw[(r & 3) + 8 * (r >> 2)] = s; }
        __syncthreads();
        {
            const float gn0 = gn_g[h_ * HD + dvh * 64 + r32], gn1 = gn_g[h_ * HD + dvh * 64 + 32 + r32];
            const char* gtp = GT + (ib * 32 + 4 * hi) * 256 + (dvh * 64 + r32) * 2; char* otp = KS + (ib * 32 + 4 * hi) * 256 + (dvh * 64 + r32) * 2;
#pragma unroll
            for (int r = 0; r < 16; ++r) { const int cr = (r & 3) + 8 * (r >> 2);
                const float rstd = __builtin_amdgcn_rsqf((ssqw[cr] + ssqp[cr]) * (1.0f / HD) + EPS);
                const float g0 = bf2f(*(const unsigned short*)(gtp + cr * 256)), g1 = bf2f(*(const unsigned short*)(gtp + cr * 256 + 64));
                const float v0 = acc[0][r] * rstd * gn0 * silu_f(g0), v1 = acc[1][r] * rstd * gn1 * silu_f(g1);
                *(unsigned short*)(otp + cr * 256) = (unsigned short)(cvtpk(v0, 0.f) & 0xffffu); *(unsigned short*)(otp + cr * 256 + 64) = (unsigned short)(cvtpk(v1, 0.f) & 0xffffu); }
        }
        __syncthreads();
        {
            unsigned char* Ow = (unsigned char*)O + rowbase_ * D + 1024 + h_ * HD;
#pragma unroll
            for (int i = 0; i < 4; ++i) { const int c = sr + 32 * i; const u32x4 w = *(const u32x4*)(KS + c * 256 + sc * 2); u32x2 o8;
                o8.x = pk_fp8x4(bflo(w.x), bfhi(w.x), bflo(w.y), bfhi(w.y)); o8.y = pk_fp8x4(bflo(w.z), bfhi(w.z), bflo(w.w), bfhi(w.w));
                *(GAS u32x2*)(Ow + (size_t)c * D + sc) = o8; }
        }
        __syncthreads();
    }
#undef RC_BASE
#undef RC_LOAD_KVG
#undef RC_LOAD_QR
}

__device__ __forceinline__ void p3_mixer(const Args& a, LAS unsigned char* ldsl, char* lds, const int g_wv, const int qoff, const int do_ret, const int pmode) {
    const bf16* U = (const bf16*)(a.ws + WS_U); bf16* O = (bf16*)(a.ws + WS_H1);
    unsigned* qhead = (unsigned*)(a.ws + WS_CTL) + CW_QHEAD + qoff;
    LAS unsigned* slot = (LAS unsigned*)(ldsl + LDSCTL_OFF) + 16;
    if ((do_ret & 1) && (int)blockIdx.x < 32) ret_state_stream(U, (bf16*)(a.ws + WS_ACT), (int)blockIdx.x, lds, g_wv);
    if (do_ret & 2) return;
    const int grp = (int)(blockIdx.x & 7);
    unsigned* cq = (unsigned*)(a.ws + WS_CTL) + CW_CVQ;
    const bool cvt_on = (qoff == 0 && pmode == 0);
#define P3_CVT_LOOP() for (;;) { __syncthreads(); if (TIDX == 0) *slot = __hip_atomic_fetch_add(cq, 1u, __ATOMIC_RELAXED, __HIP_MEMORY_SCOPE_AGENT); __syncthreads(); \
        const int clo = CV_SPLIT + (int)(*slot) * 64; if (clo >= CV_NIT) break; cvt_run<true>(a.ws, ldsl, g_wv, clo, (clo + 64 < CV_NIT) ? clo + 64 : CV_NIT, 1); }
    if (cvt_on && (((blockIdx.x >> 3) & 1u) != 0u)) { P3_CVT_LOOP(); }
    for (;;) {
        __syncthreads();
        if (TIDX == 0) *slot = __hip_atomic_fetch_add(qhead + 64 * grp + 64, 1u, __ATOMIC_RELAXED, __HIP_MEMORY_SCOPE_AGENT);
        __syncthreads();
        const unsigned it = *slot;
        if (it >= 64u) break;
        attn_item(U, pmode ? (bf16*)(a.ws + WS_ACT + 64 * MiB) : O, grp + 8 * (int)(it & 3u), 15 - (int)(it >> 2), ldsl, lds, g_wv, pmode);
    }
    if (cvt_on) { P3_CVT_LOOP(); }
#undef P3_CVT_LOOP
}
__device__ __forceinline__ void p3_ret_chunks(const Args& a, char* lds, const int g_wv) {
    const bf16* U = (const bf16*)(a.ws + WS_U); bf16* O = (bf16*)(a.ws + WS_H1);
    ret_chunk_items(U, (const bf16*)(a.ws + WS_ACT), O, a.in[I_RGN], lds, g_wv);
}
}

__device__ __forceinline__ void p5_router(const Args& a, LAS unsigned char* lds, const int g_wv, const int cbank, const int pm) {
    const int tid = TIDX, lane = tid & 63, wave = g_wv, G = gridDim.x, bx = blockIdx.x;
    const bf16* X1 = (const bf16*)(a.ws + WS_X1B); const float* modv = (const float*)(a.ws + WS_MOD); unsigned char* H2 = a.ws + WS_U;
    const float* Wr = a.in[I_WR]; const float rbias = a.in[I_RB][lane];
    unsigned* counts = (unsigned*)(a.ws + WS_CTL) + CW_CNT + cbank;
    int* LTOK = (int*)(a.ws + WS_LTOK); float* LW = (float*)(a.ws + WS_LW); unsigned* META = (unsigned*)(a.ws + WS_META);
    LAS float* h2f = (LAS float*)lds;
    constexpr int H2S = D + 8;
    LAS unsigned* lcnt = (LAS unsigned*)(lds + 16 * H2S * 4);
    LAS unsigned* lbase = lcnt + 64;
    LAS unsigned* rrec = lcnt + 128;
    LAS float* rgw = (LAS float*)(rrec + 1024);
    if (tid < 64) lcnt[tid] = 0u;
    __syncthreads();
    int ltile = 0;
    const bf16* Wrh = (const bf16*)(a.ws + WS_WR); const bf16* Wrl = Wrh + NE * D;
    f32x4 A[8], B[8]; int curb = -1;
    u32x2 vn[2][8];
    const int t0 = (int)((long)bx * (T / 16) / G), t1 = (int)((long)(bx + 1) * (T / 16) / G);
    if (t0 < t1) {
#pragma unroll
        for (int rr = 0; rr < 2; ++rr) { const GAS u32x2* xr = (const GAS u32x2*)(X1 + (size_t)(t0 * 16 + 2 * wave + rr) * D) + lane;
#pragma unroll
            for (int j = 0; j < 8; ++j) vn[rr][j] = xr[64 * j]; } }
    for (int tile = t0; tile < t1; ++tile) {
        const int row0 = tile * 16, b = row0 >> 12;
        if (b != curb) { curb = b;
#pragma unroll
            for (int j = 0; j < 8; ++j) { const int d = 4 * lane + 256 * j; const f32x4 g = *(const GAS f32x4*)(a.in[I_N2G] + d), sc = *(const GAS f32x4*)(modv + b * 16384 + 8192 + d);
                A[j] = g * (1.0f + sc); B[j] = *(const GAS f32x4*)(modv + b * 16384 + 6144 + d); } }
#pragma unroll
        for (int rr = 0; rr < 2; ++rr) { const int lr = 2 * wave + rr, row = row0 + lr;
            f32x4 v[8]; float ss = 0.f;
#pragma unroll
            for (int j = 0; j < 8; ++j) { v[j] = (f32x4){bflo(vn[rr][j].x), bfhi(vn[rr][j].x), bflo(vn[rr][j].y), bfhi(vn[rr][j].y)}; ss += (v[j].x * v[j].x + v[j].y * v[j].y) + (v[j].z * v[j].z + v[j].w * v[j].w); }
            const float rstd = __builtin_amdgcn_rsqf(wave_sum(ss) * (1.0f / D) + EPS);
            GAS unsigned* o8 = (GAS unsigned*)(H2 + (size_t)row * D) + lane;
#pragma unroll
            for (int j = 0; j < 8; ++j) { const f32x4 h = v[j] * rstd * A[j] + B[j]; o8[64 * j] = pk_fp8x4(h.x, h.y, h.z, h.w);
                *(LAS f32x4*)(h2f + lr * H2S + 4 * lane + 256 * j) = h; } }
        __syncthreads();
        f32x4 acc[4];
#pragma unroll
        for (int nt = 0; nt < 4; ++nt) acc[nt] = (f32x4){0.f, 0.f, 0.f, 0.f};
        if (pm != 1) {
            const int mrow = lane & 15, kq = lane >> 4;
            const LAS float* ap = h2f + mrow * H2S + 256 * wave + 8 * kq;
            const bf16* bph = Wrh + ((size_t)(wave * 8) * 256 + lane) * 8; const bf16* bpl = Wrl + ((size_t)(wave * 8) * 256 + lane) * 8;
#pragma unroll 2
            for (int ks = 0; ks < 8; ++ks) {
                bf16x8 bh[4], bl[4];
#pragma unroll
                for (int nt = 0; nt < 4; ++nt) { bh[nt] = *(const GAS bf16x8*)(bph + (size_t)(ks * 4 + nt) * 512); bl[nt] = *(const GAS bf16x8*)(bpl + (size_t)(ks * 4 + nt) * 512); }
                const f32x4 x0 = *(const LAS f32x4*)(ap + 32 * ks), x1 = *(const LAS f32x4*)(ap + 32 * ks + 4);
                u32x4 hw, lw;
                hw.x = cvtpk(x0.x, x0.y); hw.y = cvtpk(x0.z, x0.w); hw.z = cvtpk(x1.x, x1.y); hw.w = cvtpk(x1.z, x1.w);
                lw.x = cvtpk(x0.x - bflo(hw.x), x0.y - bfhi(hw.x)); lw.y = cvtpk(x0.z - bflo(hw.y), x0.w - bfhi(hw.y)); lw.z = cvtpk(x1.x - bflo(hw.z), x1.y - bfhi(hw.z)); lw.w = cvtpk(x1.z - bflo(hw.w), x1.w - bfhi(hw.w));
                const bf16x8 ah = *reinterpret_cast<const bf16x8*>(&hw), al = *reinterpret_cast<const bf16x8*>(&lw);
#pragma unroll
                for (int nt = 0; nt < 4; ++nt) {
                    acc[nt] = __builtin_amdgcn_mfma_f32_16x16x32_bf16(ah, bh[nt], acc[nt], 0, 0, 0);
                    acc[nt] = __builtin_amdgcn_mfma_f32_16x16x32_bf16(al, bh[nt], acc[nt], 0, 0, 0);
                    acc[nt] = __builtin_amdgcn_mfma_f32_16x16x32_bf16(ah, bl[nt], acc[nt], 0, 0, 0); }
            }
        }
        if (tile + 1 < t1) {
#pragma unroll
            for (int rr = 0; rr < 2; ++rr) { const GAS u32x2* xr = (const GAS u32x2*)(X1 + (size_t)((tile + 1) * 16 + 2 * wave + rr) * D) + lane;
#pragma unroll
                for (int j = 0; j < 8; ++j) vn[rr][j] = xr[64 * j]; } }
        __syncthreads();
        { const int col = lane & 15, rq = lane >> 4;
#pragma unroll
            for (int nt = 0; nt < 4; ++nt)
#pragma unroll
                for (int i = 0; i < 4; ++i) h2f[(wave * 16 + rq * 4 + i) * 64 + nt * 16 + col] = acc[nt][i]; }
        __syncthreads();
        if (pm == 0 || pm == 3) {
            bool sel2[2]; float gw2[2]; int jj2[2];
#pragma unroll
            for (int rr = 0; rr < 2; ++rr) { const int lr = 2 * wave + rr;
                float logit = 0.f;
#pragma unroll
                for (int w = 0; w < 8; ++w) logit += h2f[(w * 16 + lr) * 64 + lane];
                const float s = fast_rcp(1.0f + fast_exp2(-logit * LOG2E));
                const float ch = s + rbias;
                float m1 = ch; m1 = fmaxf(m1, __shfl_xor(m1, 1)); m1 = fmaxf(m1, __shfl_xor(m1, 2)); m1 = fmaxf(m1, __shfl_xor(m1, 4));
                const unsigned long long bal = __ballot(ch == m1);
                const int g = lane >> 3; const unsigned gb = (unsigned)(bal >> (8 * g)) & 0xffu; const int first = __builtin_ctz(gb | 0x100u);
                float m2 = ((lane & 7) == first) ? -__builtin_inff() : ch; m2 = fmaxf(m2, __shfl_xor(m2, 1)); m2 = fmaxf(m2, __shfl_xor(m2, 2)); m2 = fmaxf(m2, __shfl_xor(m2, 4));
                const float gs = m1 + m2;
                int grank = 0;
#pragma unroll
                for (int gg = 0; gg < 8; ++gg) { const float v = __uint_as_float(__builtin_amdgcn_readlane(__float_as_uint(gs), 8 * gg)); grank += ((v > gs) || (v == gs && gg < g)) ? 1 : 0; }
                const bool gok = grank < 4;
                const float val = gok ? ch : -__builtin_inff();
                int rank = 0;
#pragma unroll
                for (int e2 = 0; e2 < 64; ++e2) { const float v = __uint_as_float(__builtin_amdgcn_readlane(__float_as_uint(val), e2)); rank += ((v > val) || (v == val && e2 < lane)) ? 1 : 0; }
                const bool sel = gok && rank < TOPK;
                const float ssum = wave_sum(sel ? s : 0.f);
                gw2[rr] = s / ssum * 2.5f; sel2[rr] = sel;
                const unsigned long long selmask = __ballot(sel);
                jj2[rr] = __builtin_popcountll(selmask & ((1ull << lane) - 1ull)); }
#pragma unroll
            for (int rr = 0; rr < 2; ++rr) if (sel2[rr]) { const unsigned off = __hip_atomic_fetch_add((unsigned*)(lcnt + lane), 1u, __ATOMIC_RELAXED, __HIP_MEMORY_SCOPE_WORKGROUP);
                const int lrow = ltile * 16 + 2 * wave + rr; if (jj2[rr] < TOPK) { rrec[lrow * 8 + jj2[rr]] = ((unsigned)lane << 16) | off; rgw[lrow * 8 + jj2[rr]] = gw2[rr]; } }
        }
        __syncthreads();
        ++ltile;
    }
    if (pm == 0 || pm == 3) {
        if (tid < 64) lbase[tid] = __hip_atomic_fetch_add(counts + 16 * tid, lcnt[tid], __ATOMIC_RELAXED, __HIP_MEMORY_SCOPE_AGENT);
        __syncthreads();
        for (int i = tid; i < ltile * 128; i += NTHR) { const int lrow = i >> 3, j = i & 7; const unsigned rec = rrec[i]; const int e = (int)(rec >> 16), slot = (int)(lbase[e] + (rec & 0xffffu));
            const int grow = (t0 + (lrow >> 4)) * 16 + (lrow & 15);
            LTOK[e * T + slot] = grow; LW[e * T + slot] = rgw[i]; META[grow * TOPK + j] = ((unsigned)e << 16) | (unsigned)slot; }
    }
}

struct MUnit { int e, pos0, s0, nv, pn; };
constexpr int TL_OFF = 131072, SEGB_OFF = 131072 + 8192;
__device__ __forceinline__ int build_tiles(const unsigned* counts, LAS int* tl, LAS int* segb, int xg, const int g_wv, const bool want_tiles) {
    const int tid = TIDX, lane = tid & 63;
    LAS int* ntl = segb + 80;
    if (tid < 64) {
        const int cnt = (int)__hip_atomic_load(counts + 16 * lane, __ATOMIC_RELAXED, __HIP_MEMORY_SCOPE_AGENT);
        const int nt = (cnt + 255) >> 8;
        int inc = nt;
#pragma unroll
        for (int o = 1; o < 64; o <<= 1) { const int v = __shfl_up(inc, o); if (lane >= o) inc += v; }
        const int st = inc - nt;
        segb[lane] = st * 256;
        if (want_tiles) {
            int rank = 0;
#pragma unroll
            for (int e2 = 0; e2 < 64; ++e2) { const int v = __builtin_amdgcn_readlane(nt, e2); rank += ((v > nt) || (v == nt && e2 < lane)) ? 1 : 0; }
            ntl[rank] = nt;
            asm volatile("s_waitcnt lgkmcnt(0)" ::: "memory");
            const int k = rank >> 3, q = rank & 7, grp = (k & 1) ? 7 - q : q;
            int loc = 0, tot = 0;
#pragma unroll
            for (int j = 0; j < 8; ++j) { const int v = ntl[8 * j + ((j & 1) ? 7 - grp : grp)]; if (j < k) loc += v; }
            { const int g = lane & 7;
#pragma unroll
              for (int j = 0; j < 8; ++j) tot += ntl[8 * j + ((j & 1) ? 7 - g : g)]; }
            int totg[8], mn = 1 << 30;
#pragma unroll
            for (int g = 0; g < 8; ++g) { totg[g] = __builtin_amdgcn_readlane(tot, g); mn = totg[g] < mn ? totg[g] : mn; }
            int L = mn;
            for (int it = 0; it < 4096; ++it) { int s = 0;
#pragma unroll
                for (int g = 0; g < 8; ++g) s += (L - totg[g]) > 0 ? (L - totg[g]) : 0;
                if (s >= 64) break; ++L; }
            int ns[8], sum = 0;
#pragma unroll
            for (int g = 0; g < 8; ++g) { ns[g] = (L - totg[g]) > 0 ? (L - totg[g]) : 0; sum += ns[g]; }
            int excess = sum - 64;
#pragma unroll
            for (int g = 0; g < 8; ++g) { if (excess > 0 && ns[g] > 0) { --ns[g]; --excess; } }
            int shstart = 0, mytot = 0, myns = 0;
#pragma unroll
            for (int g = 0; g < 8; ++g) { if (g < xg) shstart += ns[g]; if (g == xg) { mytot = totg[g]; myns = ns[g]; } }
            if (grp == xg) for (int t = 0; t < nt; ++t) { const int nv = (cnt - 256 * t) < 256 ? (cnt - 256 * t) : 256; tl[2 * (loc + t)] = lane | (nv << 8) | (t << 18); tl[2 * (loc + t) + 1] = st * 256 + 256 * t; }
            if (lane < myns) { const int mt = shstart + lane; tl[2 * (mytot + lane)] = 64 | (256 << 8) | (mt << 18); tl[2 * (mytot + lane) + 1] = SH_POS0 + 256 * mt; }
            if (lane == 0) segb[64] = mytot + myns;
        }
    }
    __syncthreads();
    return want_tiles ? __builtin_amdgcn_readfirstlane(segb[64]) : 0;
}
template <bool GATHER, int NPNS  >
struct MoeOrder {
    typedef MUnit Unit;
    const LAS int* tl; int ntile, j, stride, K; const int* ltok;
    __device__ __forceinline__ bool next(int i, MUnit& u) const {
        const int idx = j + stride * i, tile = idx >> NPNS; if (tile >= ntile) return false;
        const int w0 = tl[2 * tile], w1 = tl[2 * tile + 1];
        u.e = w0 & 0xff; u.nv = (w0 >> 8) & 0x3ff; u.s0 = (w0 >> 18) << 8; u.pos0 = w1; u.pn = idx & ((1 << NPNS) - 1); return true;
    }
    __device__ __forceinline__ void a_offs(const MUnit& u, int tid, unsigned (&ao)[2][2]) const {
        int lt[2][2] = {{0, 0}, {0, 0}};
        if (GATHER) {
            const int* lte = ltok + (u.e < 64 ? u.e : 63) * T + u.s0; const int rmax = u.nv - 1;
#pragma unroll
            for (int i = 0; i < 2; ++i) { int R, C; pg8::stage_rc(tid * 16 + i * 8192, R, C);
#pragma unroll
                for (int h = 0; h < 2; ++h) { const int r = h * 128 + R; lt[h][i] = lte[r < rmax ? r : rmax]; } }
            asm volatile("" : "+v"(lt[0][0]), "+v"(lt[0][1]), "+v"(lt[1][0]), "+v"(lt[1][1]));
        }
#pragma unroll
        for (int i = 0; i < 2; ++i) { int R, C; pg8::stage_rc(tid * 16 + i * 8192, R, C);
#pragma unroll
            for (int h = 0; h < 2; ++h) { const int r = h * 128 + R;
                if (GATHER) { const int tok = (u.e != 64) ? ((r < u.nv) ? lt[h][i] : 0) : (u.s0 + r); ao[h][i] = (unsigned)((tok * K + C) * 2); }
                else ao[h][i] = (unsigned)(((u.pos0 + r) * K + C) * 2); } }
    }
    __device__ __forceinline__ size_t b_off(const MUnit& u) const { return (size_t)((GATHER ? u.e * 1024 : u.e * 2048) + u.pn * 256) * K * 2; }
    static constexpr bool LANE_CONST = !GATHER;
    __device__ __forceinline__ unsigned a_base(const MUnit& u) const { return (unsigned)u.pos0 * (unsigned)(K * 2); }
    __device__ __forceinline__ void a_lane(int tid, unsigned (&vo)[2]) const {
#pragma unroll
        for (int i = 0; i < 2; ++i) { int R, C; pg8::stage_rc(tid * 16 + i * 8192, R, C); vo[i] = (unsigned)((R * K + C) * 2); }
    }
};
struct EpiGateUp {
    static constexpr int PERM = 1; static constexpr bool FP8 = true;
    unsigned char* ACT; const float* lw;
    __device__ __forceinline__ void operator()(const f32x4 (&acc)[2][2][4][2], const MUnit& u, int wr, int wc, int fr, int fq) const {
        float gwv[2][4];
        { const float* lwe = lw + (size_t)__builtin_amdgcn_readfirstlane((u.e < 64 ? u.e : 63) * T + u.s0); const int rmax = u.nv - 1;
#pragma unroll
          for (int ai = 0; ai < 2; ++ai)
#pragma unroll
            for (int m = 0; m < 4; ++m) { const int r = ai * 128 + wr * 64 + m * 16 + fr; const char* lb_ = (const char*)lwe; asm volatile("" : "+s"(lb_));
                unsigned o_ = 4u * (unsigned)(r < rmax ? r : rmax); asm volatile("" : "+v"(o_)); gwv[ai][m] = *(const GAS float*)(lb_ + o_); } }
#pragma unroll
        for (int ai = 0; ai < 2; ++ai)
#pragma unroll
            for (int m = 0; m < 4; ++m) { const int r = ai * 128 + wr * 64 + m * 16 + fr;
                const float kk = ((u.e != 64) ? ((r < u.nv) ? gwv[ai][m] : 0.f) : 1.0f) * (ASCALE / (WSCALE * WSCALE));
                u32x2 w;
#define ACT4(G_, U_, out_) do { const f32x4 x_ = (G_) * (-LOG2E / WSCALE); f32x4 e_; e_.x = fast_exp2(x_.x); e_.y = fast_exp2(x_.y); e_.z = fast_exp2(x_.z); e_.w = fast_exp2(x_.w); \
                    const f32x4 d_ = e_ + 1.0f; f32x4 s_; s_.x = fast_rcp(d_.x); s_.y = fast_rcp(d_.y); s_.z = fast_rcp(d_.z); s_.w = fast_rcp(d_.w); \
                    const f32x4 a_ = ((G_) * (U_)) * (s_ * kk); \
                    out_ = pk_fp8x4(__builtin_amdgcn_fmed3f(a_.x, -448.0f, 448.0f), __builtin_amdgcn_fmed3f(a_.y, -448.0f, 448.0f), __builtin_amdgcn_fmed3f(a_.z, -448.0f, 448.0f), __builtin_amdgcn_fmed3f(a_.w, -448.0f, 448.0f)); } while (0)
                ACT4(acc[ai][0][m][0], acc[ai][1][m][0], w.x);
                ACT4(acc[ai][0][m][1], acc[ai][1][m][1], w.y);
#undef ACT4
                { unsigned char* ab_ = ACT + (size_t)__builtin_amdgcn_readfirstlane(u.pos0) * FE + __builtin_amdgcn_readfirstlane(u.pn) * 128; asm volatile("" : "+s"(ab_)); unsigned o_ = (unsigned)(r * FE + wc * 32 + 8 * fq); asm volatile("" : "+v"(o_));
                  *(GAS u32x2*)(ab_ + o_) = w; } }
    }
};
struct EpiDown {
    static constexpr int PERM = 3; static constexpr bool FP8 = true;
    unsigned char* OUT; bf16* X1; const float* modv; int skip_shared; LAS unsigned char* lds;
    __device__ __forceinline__ void operator()(const f32x4 (&acc)[2][2][4][2], const MUnit& u, int wr, int wc, int fr, int fq) const {
        const int col0 = u.pn * 256 + wc * 64 + 16 * fq;
        if (u.e == 64 && skip_shared) return;
        if (u.e != 64) {
            const int pr = wr * 2 + (wc >> 1), l_ = fq * 16 + fr, rho = (l_ >> 3) + 8 * (wc & 1);
            constexpr float DS = 1.0f / (WSCALE * ASCALE);
#pragma unroll
            for (int q = 0; q < 4; ++q) { const int ai = q >> 1;
                LAS unsigned char* blk[2];
#pragma unroll
                for (int s2 = 0; s2 < 2; ++s2) { const int bi = s2 * 4 + pr;
                    blk[s2] = lds + (((q & 1) == 0) ? (49152 + bi * 2048) : (bi < 7 ? (XCH_OFF + bi * 2048) : XCH_LAST_OFF)); }
#pragma unroll
                for (int s2 = 0; s2 < 2; ++s2) { const int m = 2 * (q & 1) + s2;
                    const f32x4 a0 = acc[ai][0][m][0] * DS, a1 = acc[ai][0][m][1] * DS, b0 = acc[ai][1][m][0] * DS, b1 = acc[ai][1][m][1] * DS;
                    u32x4 w; w.x = pk_fp8x4(a0.x, a0.y, a0.z, a0.w); w.y = pk_fp8x4(a1.x, a1.y, a1.z, a1.w); w.z = pk_fp8x4(b0.x, b0.y, b0.z, b0.w); w.w = pk_fp8x4(b1.x, b1.y, b1.z, b1.w);
                    *(LAS u32x4*)(blk[s2] + fr * 128 + (((wc & 1) * 64 + fq * 16) ^ ((fr & 7) << 4))) = w; }
                asm volatile("s_waitcnt lgkmcnt(0)" ::: "memory"); __builtin_amdgcn_s_barrier(); asm volatile("" ::: "memory");
#pragma unroll
                for (int s2 = 0; s2 < 2; ++s2) { const int m = 2 * (q & 1) + s2;
                    const u32x4 w = *(const LAS u32x4*)(blk[s2] + rho * 128 + (((l_ & 7) * 16) ^ ((rho & 7) << 4)));
                    __builtin_nontemporal_store(w, (GAS u32x4*)(OUT + (size_t)(u.pos0 + ai * 128 + wr * 64 + m * 16 + rho) * D + u.pn * 256 + (wc >> 1) * 128 + (l_ & 7) * 16)); }
            }
        } else {
            const int b = u.s0 >> 12;
            f32x4 gv[2][2];
#pragma unroll
            for (int bj = 0; bj < 2; ++bj)
#pragma unroll
                for (int n = 0; n < 2; ++n) gv[bj][n] = *(const GAS f32x4*)(modv + b * 16384 + 10240 + col0 + bj * 8 + 4 * n) * (1.0f / (WSCALE * ASCALE));
#pragma unroll
            for (int ai = 0; ai < 2; ++ai) {
                u32x4 xw[4][2];
#pragma unroll
                for (int m = 0; m < 4; ++m) { const int r = ai * 128 + wr * 64 + m * 16 + fr; const bf16* rowp = X1 + (size_t)(u.s0 + r) * D + col0;
#pragma unroll
                    for (int bj = 0; bj < 2; ++bj) xw[m][bj] = *(const GAS u32x4*)(rowp + bj * 8); }
#pragma unroll
                for (int m = 0; m < 4; ++m) { const int r = ai * 128 + wr * 64 + m * 16 + fr; bf16* rowp = X1 + (size_t)(u.s0 + r) * D + col0;
#pragma unroll
                    for (int bj = 0; bj < 2; ++bj) { const u32x4 w = xw[m][bj];
                        const f32x4 r0 = (f32x4){bflo(w.x), bfhi(w.x), bflo(w.y), bfhi(w.y)} + gv[bj][0] * acc[ai][bj][m][0], r1 = (f32x4){bflo(w.z), bfhi(w.z), bflo(w.w), bfhi(w.w)} + gv[bj][1] * acc[ai][bj][m][1];
                        u32x4 o; o.x = cvtpk(r0.x, r0.y); o.y = cvtpk(r0.z, r0.w); o.z = cvtpk(r1.x, r1.y); o.w = cvtpk(r1.z, r1.w);
                        *(GAS u32x4*)(rowp + bj * 8) = o; } }
            }
        }
    }
};

__device__ __forceinline__ void p8_final(const Args& a, LAS unsigned char* lds, const int g_wv, float* Xo) {
    const int tid = TIDX, lane = tid & 63, wave = g_wv;
    const int gw = blockIdx.x * NWAVES + wave, NGW = gridDim.x * NWAVES;
    const float* modv = (const float*)(a.ws + WS_MOD); const unsigned char* OUT = (const unsigned char*)(a.ws + WS_OUT); const unsigned* META = (const unsigned*)(a.ws + WS_META);
    const bf16* X = (const bf16*)(a.ws + WS_X1B);
    LAS int* tl = (LAS int*)(lds + TL_OFF); LAS int* segb = (LAS int*)(lds + SEGB_OFF);
    (void)build_tiles((const unsigned*)(a.ws + WS_CTL) + CW_CNT, tl, segb, (int)(blockIdx.x & 7), g_wv, false);
    f32x4 A[8], B[8]; int curb = -1;
    for (int row = (int)((long)gw * T / NGW), rowe = (int)((long)(gw + 1) * T / NGW); row < rowe; ++row) {
        const int b = row >> 12;
        if (b != curb) { curb = b;
#pragma unroll
            for (int i = 0; i < 8; ++i) { const int d = 4 * lane + 256 * i; const f32x4 g = *(const GAS f32x4*)(a.in[I_NFG] + d), sc = *(const GAS f32x4*)(modv + b * 16384 + 14336 + d);
                A[i] = g * (1.0f + sc); B[i] = *(const GAS f32x4*)(modv + b * 16384 + 12288 + d); } }
        f32x4 y[8];
#pragma unroll
        for (int i = 0; i < 8; ++i) y[i] = (f32x4){0.f, 0.f, 0.f, 0.f};
        const u32x4 m0 = *(const GAS u32x4*)(META + (size_t)row * 8), m1 = *(const GAS u32x4*)(META + (size_t)row * 8 + 4);
        const unsigned mm[8] = {m0.x, m0.y, m0.z, m0.w, m1.x, m1.y, m1.z, m1.w};
#pragma unroll
        for (int k = 0; k < 8; ++k) { const int e = (int)(mm[k] >> 16) & 63, slot = (int)(mm[k] & 0xffffu); const unsigned char* orow = OUT + (size_t)(segb[e] + slot) * D + 4 * lane;
#pragma unroll
            for (int i = 0; i < 8; ++i) { const unsigned w = __builtin_nontemporal_load((const GAS unsigned*)(orow + 256 * i));
                const f32x2 lo = __builtin_amdgcn_cvt_pk_f32_fp8((int)w, false), hi = __builtin_amdgcn_cvt_pk_f32_fp8((int)w, true);
                y[i] += (f32x4){lo.x, lo.y, hi.x, hi.y}; } }
        float ss = 0.f; f32x4 v[8];
#pragma unroll
        for (int i = 0; i < 8; ++i) { const u32x2 xw = *(const GAS u32x2*)(X + (size_t)row * D + 4 * lane + 256 * i); const f32x4 xv = {bflo(xw.x), bfhi(xw.x), bflo(xw.y), bfhi(xw.y)}; const f32x4 g2 = *(const GAS f32x4*)(modv + b * 16384 + 10240 + 4 * lane + 256 * i); v[i] = xv + g2 * y[i];
            ss += (v[i].x * v[i].x + v[i].y * v[i].y) + (v[i].z * v[i].z + v[i].w * v[i].w); }
        const float rstd = __builtin_amdgcn_rsqf(wave_sum(ss) * (1.0f / D) + EPS);
#pragma unroll
        for (int i = 0; i < 8; ++i) __builtin_nontemporal_store(v[i] * rstd * A[i] + B[i], (GAS f32x4*)(Xo + (size_t)row * D + 4 * lane + 256 * i));
    }
}

__global__ void __launch_bounds__(NTHR, 2) fwd_kernel(Args args) {
    extern __shared__ __attribute__((aligned(16))) unsigned char lds_raw[];
    LAS unsigned char* lds = (LAS unsigned char*)lds_raw;
    const int g_wv = __builtin_amdgcn_readfirstlane((int)threadIdx.x >> 6);
    { const int tid = TIDX; for (int u = tid; u < 256; u += NTHR) ((LAS unsigned*)(lds + LDSCTL_OFF))[u] = 0u; }
    __syncthreads();
    if (TIDX == 0) { LAS unsigned long long* pt = (LAS unsigned long long*)(lds + LDSCTL_OFF + 256);
        pt[0] = (unsigned long long)(uintptr_t)args.in[I_WIN]; pt[1] = (unsigned long long)(uintptr_t)args.in[I_WOUT]; pt[2] = (unsigned long long)(uintptr_t)args.in[I_WG]; pt[3] = (unsigned long long)(uintptr_t)args.in[I_WU];
        pt[4] = (unsigned long long)(uintptr_t)args.in[I_WDN]; pt[5] = (unsigned long long)(uintptr_t)args.in[I_SG]; pt[6] = (unsigned long long)(uintptr_t)args.in[I_SU]; pt[7] = (unsigned long long)(uintptr_t)args.in[I_SD]; }
    __syncthreads();
    unsigned* ctl = (unsigned*)(args.ws + WS_CTL);
    const int lo = args.ph_lo, hi = args.ph_hi;
    XcdBarrier bar; bar.bar = ctl + CW_BAR; bar.x = 0; bar.st = nullptr;
    if (hi - lo > 1) bar = xcd_barrier_post(ctl + CW_BAR, (volatile LAS unsigned*)(lds + LDSCTL_OFF) + 8, g_wv);
#define IN(k) (lo <= (k) && (k) < hi)
#define SEAM(k) do { if (IN(k) && IN((k) + 1)) xcd_barrier(bar, g_wv); } while (0)
    float* modv = (float*)(args.ws + WS_MOD);
#define DUP(k) (DUP_PHASE == (k))
    if (IN(0)) { p0_prologue(args, lds, g_wv); if (DUP(0)) { xcd_barrier(bar, g_wv); p0_prologue(args, lds, g_wv); } } SEAM(0);
    if (IN(1)) { norm_rows_bf16<true>(args.in[I_X], args.in[I_N1G], modv, 0, 2048, (bf16*)(args.ws + WS_H1), g_wv);
        if (DUP(1)) { xcd_barrier(bar, g_wv); norm_rows_bf16<true>(args.in[I_X], args.in[I_N1G], modv, 0, 2048, (bf16*)(args.ws + WS_H1), g_wv); } } SEAM(1);
    if (IN(2)) {
        const int nu = (1792 + (int)gridDim.x - 1) / (int)gridDim.x, s = ((blockIdx.x >> 3) & 1u) ? (nu + 1) / 2 : 0;
        { pg8::DenseOrder S1; S1.init(T, INC, D / 2, (int)gridDim.x, (int)blockIdx.x); S1.cnt = s; EpiQKV E1{(bf16*)(args.ws + WS_U), (const float*)(args.ws + WS_ROPE), 0};
          pg8::gemm_phase<pg8::DenseOrder, EpiQKV, true, true>(lds, (const char*)(args.ws + WS_H1), (const char*)(args.ws + WS_WIN), D / 2, S1, E1, g_wv); }
        cvt_run<true>(args.ws, lds, g_wv, CV_EARLY, CV_SPLIT); __syncthreads();
        { pg8::DenseOrder S2; S2.init(T, INC, D / 2, (int)gridDim.x, (int)blockIdx.x); S2.i0 = s; EpiQKV E2{(bf16*)(args.ws + WS_U), (const float*)(args.ws + WS_ROPE), 0};
          pg8::gemm_phase<pg8::DenseOrder, EpiQKV, true, true>(lds, (const char*)(args.ws + WS_H1), (const char*)(args.ws + WS_WIN), D / 2, S2, E2, g_wv); }
        if (DUP(2)) { xcd_barrier(bar, g_wv); pg8::DenseOrder S; S.init(T, INC, D / 2, (int)gridDim.x, (int)blockIdx.x); EpiQKV E{(bf16*)(args.ws + WS_U), (const float*)(args.ws + WS_ROPE), 0};
            pg8::gemm_phase<pg8::DenseOrder, EpiQKV, true, true>(lds, (const char*)(args.ws + WS_H1), (const char*)(args.ws + WS_WIN), D / 2, S, E, g_wv); }
    } SEAM(2);
    if (IN(3)) { mix::p3_mixer(args, lds, (char*)lds_raw, g_wv, 0, 1, 0); if (DUP(3)) { xcd_barrier(bar, g_wv); mix::p3_mixer(args, lds, (char*)lds_raw, g_wv, 1024, 1, 0); } if (DUP(13)) { xcd_barrier(bar, g_wv); mix::p3_mixer(args, lds, (char*)lds_raw, g_wv, 1024, 0, 0); } if (DUP(16)) { xcd_barrier(bar, g_wv); mix::p3_mixer(args, lds, (char*)lds_raw, g_wv, 1024, 0, 1); } if (DUP(17)) { xcd_barrier(bar, g_wv); mix::p3_mixer(args, lds, (char*)lds_raw, g_wv, 1024, 0, 2); } if (DUP(18)) { xcd_barrier(bar, g_wv); mix::p3_mixer(args, lds, (char*)lds_raw, g_wv, 1024, 0, 3); } if (DUP(19)) { xcd_barrier(bar, g_wv); mix::p3_mixer(args, lds, (char*)lds_raw, g_wv, 1024, 0, 4); } if (DUP(20)) { xcd_barrier(bar, g_wv); mix::p3_mixer(args, lds, (char*)lds_raw, g_wv, 1024, 0, 5); } if (DUP(15)) { xcd_barrier(bar, g_wv); mix::p3_mixer(args, lds, (char*)lds_raw, g_wv, 1024, 3, 0); }
        xcd_barrier(bar, g_wv); mix::p3_ret_chunks(args, (char*)lds_raw, g_wv); if (DUP(14)) { xcd_barrier(bar, g_wv); mix::p3_ret_chunks(args, (char*)lds_raw, g_wv); } } SEAM(3);
    if (IN(4)) { pg8::DenseOrder S; S.init(T, D, D / 2, (int)gridDim.x, (int)blockIdx.x);
        EpiResid E{args.in[I_X], (bf16*)(args.ws + WS_X1B), modv};
        pg8::gemm_phase<pg8::DenseOrder, EpiResid, true, true>(lds, (const char*)(args.ws + WS_H1), (const char*)(args.ws + WS_WOUT), D / 2, S, E, g_wv);
        if (DUP(4)) { xcd_barrier(bar, g_wv); pg8::gemm_phase<pg8::DenseOrder, EpiResid, true, true>(lds, (const char*)(args.ws + WS_H1), (const char*)(args.ws + WS_WOUT), D / 2, S, E, g_wv); } } SEAM(4);
    if (IN(5)) { if (DUP(5)) { p5_router(args, lds, g_wv, 2048, 3); xcd_barrier(bar, g_wv); } if (DUP(51)) { p5_router(args, lds, g_wv, 2048, 1); xcd_barrier(bar, g_wv); } if (DUP(52)) { p5_router(args, lds, g_wv, 2048, 2); xcd_barrier(bar, g_wv); } p5_router(args, lds, g_wv, 0, 0); } SEAM(5);
    if (IN(6)) { LAS int* tl = (LAS int*)(lds + TL_OFF); LAS int* segb = (LAS int*)(lds + SEGB_OFF);
        const int ntile = build_tiles(ctl + CW_CNT, tl, segb, (int)(blockIdx.x & 7), g_wv, true);
        MoeOrder<true, 2> S{tl, ntile, (int)(blockIdx.x >> 3), (int)(gridDim.x >> 3), D / 2, (const int*)(args.ws + WS_LTOK)};
        EpiGateUp E{args.ws + WS_ACT, (const float*)(args.ws + WS_LW)};
        pg8::gemm_phase<MoeOrder<true, 2>, EpiGateUp, true, true>(lds, (const char*)(args.ws + WS_U), (const char*)(args.ws + WS_WGU), D / 2, S, E, g_wv);
        if (DUP(6)) { xcd_barrier(bar, g_wv); pg8::gemm_phase<MoeOrder<true, 2>, EpiGateUp, true, true>(lds, (const char*)(args.ws + WS_U), (const char*)(args.ws + WS_WGU), D / 2, S, E, g_wv); }
        if (DUP(61)) { pg8::gemm_phase<MoeOrder<true, 2>, EpiGateUp, true, true, 1>(lds, (const char*)(args.ws + WS_U), (const char*)(args.ws + WS_WGU), D / 2, S, E, g_wv); xcd_barrier(bar, g_wv); pg8::gemm_phase<MoeOrder<true, 2>, EpiGateUp, true, true>(lds, (const char*)(args.ws + WS_U), (const char*)(args.ws + WS_WGU), D / 2, S, E, g_wv); }
        if (DUP(62)) { pg8::gemm_phase<MoeOrder<true, 2>, EpiGateUp, true, true, 2>(lds, (const char*)(args.ws + WS_U), (const char*)(args.ws + WS_WGU), D / 2, S, E, g_wv); xcd_barrier(bar, g_wv); pg8::gemm_phase<MoeOrder<true, 2>, EpiGateUp, true, true>(lds, (const char*)(args.ws + WS_U), (const char*)(args.ws + WS_WGU), D / 2, S, E, g_wv); } } SEAM(6);
    if (IN(7)) { LAS int* tl = (LAS int*)(lds + TL_OFF); LAS int* segb = (LAS int*)(lds + SEGB_OFF);
        const int ntile = build_tiles(ctl + CW_CNT, tl, segb, (int)(blockIdx.x & 7), g_wv, true);
        MoeOrder<false, 3> S{tl, ntile, (int)(blockIdx.x >> 3), (int)(gridDim.x >> 3), FE / 2, nullptr};
        if (DUP(7)) { EpiDown E0{(unsigned char*)(args.ws + WS_OUT), (bf16*)(args.ws + WS_X1B), modv, 1, lds};
            pg8::gemm_phase<MoeOrder<false, 3>, EpiDown, true, true>(lds, (const char*)(args.ws + WS_ACT), (const char*)(args.ws + WS_WD), FE / 2, S, E0, g_wv); xcd_barrier(bar, g_wv); }
        EpiDown E{(unsigned char*)(args.ws + WS_OUT), (bf16*)(args.ws + WS_X1B), modv, 0, lds};
        pg8::gemm_phase<MoeOrder<false, 3>, EpiDown, true, true>(lds, (const char*)(args.ws + WS_ACT), (const char*)(args.ws + WS_WD), FE / 2, S, E, g_wv); } SEAM(7);
    if (DUP(99)) { for (int q = 0; q < 10; ++q) xcd_barrier(bar, g_wv); }
    if (IN(8)) { if (DUP(8)) { p8_final(args, lds, g_wv, (float*)(args.ws + WS_ACT)); xcd_barrier(bar, g_wv); } p8_final(args, lds, g_wv, args.out); }
#undef IN
#undef SEAM
}

#ifndef MK_ONE_LAUNCH
#define MK_ONE_LAUNCH 1
#endif
extern "C" void kernel_launch(void* const* d_in, const int* in_sizes, int n_in, void* d_out, int out_size, void* d_ws, size_t ws_size, hipStream_t stream) {
    static int grid = 0;
    if (grid == 0) {
        if (n_in != 20 || out_size != T * D || ws_size < WS_END) { fprintf(stderr, "kernel_launch: unexpected shapes (n_in %d out %d ws %zu need %zu)\n", n_in, out_size, ws_size, (size_t)WS_END); grid = -1; return; }
        int dev = 0, cus = 0, per_cu = 0;
        if (hipGetDevice(&dev) != hipSuccess || hipDeviceGetAttribute(&cus, hipDeviceAttributeMultiprocessorCount, dev) != hipSuccess) { grid = -1; return; }
        if (hipFuncSetAttribute((const void*)fwd_kernel, hipFuncAttributeMaxDynamicSharedMemorySize, LDS_BYTES) != hipSuccess) { fprintf(stderr, "kernel_launch: hipFuncSetAttribute failed\n"); grid = -1; return; }
        if (hipOccupancyMaxActiveBlocksPerMultiprocessor(&per_cu, (const void*)fwd_kernel, NTHR, LDS_BYTES) != hipSuccess || per_cu < 1) fprintf(stderr, "kernel_launch: occupancy query says %d\n", per_cu);
        (void)hipGetLastError();
        grid = cus & ~7;
        if (grid < 128) { fprintf(stderr, "kernel_launch: %d CUs: this kernel is built for a 256-CU MI355X (needs >= 128)\n", cus); grid = -1; return; }
    }
    if (grid < 0) return;
    (void)hipMemsetAsync((char*)d_ws + WS_CTL, 0, CTL_ZERO_BYTES, stream);
    Args a{};
    for (int i = 0; i < 20; ++i) a.in[i] = (const float*)d_in[i];
    a.out = (float*)d_out; a.ws = (unsigned char*)d_ws;
#if MK_ONE_LAUNCH
    a.ph_lo = 0; a.ph_hi = NPH;
    hipLaunchKernelGGL(fwd_kernel, dim3(grid), dim3(NTHR), LDS_BYTES, stream, a);
#else
    for (int p = 0; p < NPH; ++p) { a.ph_lo = p; a.ph_hi = p + 1; hipLaunchKernelGGL(fwd_kernel, dim3(grid), dim3(NTHR), LDS_BYTES, stream, a); }
#endif
}
```
